# Optimizing an MI355X kernel written in HIP

```python
import jax, jax.numpy as jnp
from jax import lax
import numpy as np

D_MODEL = 2048
BATCH = 4
SEQ = 2048
DEPTH = 2

MIX_WIDTH = D_MODEL
GLA_HEADS = 4
GLA_DV = MIX_WIDTH // 2 // GLA_HEADS
GLA_DK = GLA_DV // 2
GLA_GATE_RANK = 16
GLA_GATE_TAU = 16.0
GLA_CHUNK = 64
DIL_HEADS = 8
DIL_DH = (MIX_WIDTH - GLA_HEADS * GLA_DV) // DIL_HEADS
DIL_PATTERNS = ((128, 1), (512, 4), (2048, 16))
DIL_BLOCK = 128
REL_BUCKETS = 32
REL_MAX_DIST = 2048
FFN_HIDDEN = -(-8 * D_MODEL // (3 * 256)) * 256
RMS_EPS = 1e-6
NEG_INF = -1e30

SPLIT_SIZES = (
    GLA_HEADS * GLA_DK,
    GLA_HEADS * GLA_DK,
    GLA_HEADS * GLA_DV,
    GLA_HEADS * GLA_DV,
    GLA_GATE_RANK,
    DIL_HEADS * DIL_DH,
    DIL_HEADS * DIL_DH,
    DIL_HEADS * DIL_DH,
)
N_IN = sum(SPLIT_SIZES)

kernel_name = "hybrid_gla_dilated_parallel_heads"


def rms_norm(x, g):
    xf = x.astype(jnp.float32)
    y = xf * lax.rsqrt(jnp.mean(xf * xf, axis=-1, keepdims=True) + RMS_EPS)
    return (y * g.astype(jnp.float32)).astype(x.dtype)


def t5_bucket(dist):
    max_exact = REL_BUCKETS // 2
    safe = np.maximum(dist, 1)
    large = max_exact + (np.log(safe / max_exact) / np.log(REL_MAX_DIST / max_exact)
                         * (REL_BUCKETS - max_exact)).astype(np.int64)
    large = np.minimum(large, REL_BUCKETS - 1)
    return np.where(dist < max_exact, dist, large).astype(np.int32)


def gla_mixer(q, k, v, r, log_g, onorm_g):
    Bsz, S, H, DK = q.shape
    DV = v.shape[-1]
    C = GLA_CHUNK
    N = S // C

    def chunks(t):
        return t.astype(jnp.float32).reshape(Bsz, N, C, H, t.shape[-1]).transpose(0, 3, 1, 2, 4)

    qc = chunks(q) * (DK ** -0.5)
    kc, vc, gc = chunks(k), chunks(v), chunks(log_g)
    b = jnp.cumsum(gc, axis=3)
    q_t = qc * jnp.exp(b)
    k_t = kc * jnp.exp(-b)
    causal = np.tril(np.ones((C, C), dtype=bool))
    attn = jnp.einsum('bhnid,bhnjd->bhnij', q_t, k_t)
    attn = jnp.where(causal, attn, 0.0)
    o_intra = jnp.einsum('bhnij,bhnjv->bhniv', attn, vc)

    b_last = b[:, :, :, -1, :]
    k_dec = kc * jnp.exp(b_last[:, :, :, None, :] - b)
    chunk_state = jnp.einsum('bhncd,bhncv->bhndv', k_dec, vc)

    def step(state, inp):
        q_n, decay_n, cs_n = inp
        o_n = jnp.einsum('bhcd,bhdv->bhcv', q_n, state)
        state = decay_n[..., None] * state + cs_n
        return state, o_n

    init = jnp.zeros((Bsz, H, DK, DV), jnp.float32)
    xs = (q_t.transpose(2, 0, 1, 3, 4), jnp.exp(b_last).transpose(2, 0, 1, 3),
          chunk_state.transpose(2, 0, 1, 3, 4))
    _, o_inter = lax.scan(step, init, xs)
    o = o_intra + o_inter.transpose(1, 2, 0, 3, 4)
    o = o.transpose(0, 2, 3, 1, 4).reshape(Bsz, S, H, DV)
    o = rms_norm(o, onorm_g)
    o = o.reshape(Bsz, S, H * DV) * jax.nn.silu(r.astype(jnp.float32))
    return o


def dilated_branch(q, k, v, rel_bias, window, dilation):
    Bsz, H, S, Dh = q.shape
    span = window // dilation
    Q = DIL_BLOCK
    seg = dilation * Q
    Sp = -(-S // seg) * seg
    L = Sp // dilation
    nb = L // Q

    def to_blocks(t):
        t = jnp.pad(t, ((0, 0), (0, 0), (0, Sp - S), (0, 0)))
        return t.reshape(Bsz, H, L, dilation, Dh).transpose(0, 1, 3, 2, 4).reshape(Bsz, H, dilation, nb, Q, Dh)

    qb, kb, vb = to_blocks(q), to_blocks(k), to_blocks(v)
    blk_pad = ((0, 0), (0, 0), (0, 0), (1, 0), (0, 0), (0, 0))
    kk = jnp.concatenate([jnp.pad(kb[:, :, :, :-1], blk_pad), kb], axis=4)
    vv = jnp.concatenate([jnp.pad(vb[:, :, :, :-1], blk_pad), vb], axis=4)

    i = np.arange(Q)[:, None]
    j = np.arange(2 * Q)[None, :]
    rel = Q + i - j
    band = (rel >= 0) & (rel <= span)
    valid = band[None] & ((np.arange(nb)[:, None, None] > 0) | (j >= Q)[None])
    buckets = t5_bucket(np.clip(rel, 0, None) * dilation)
    bias = jnp.take(rel_bias.astype(jnp.float32), buckets, axis=0).transpose(2, 0, 1)

    logits = jnp.einsum('bhrnqd,bhrnkd->bhrnqk', qb, kk) * (Dh ** -0.5)
    logits = logits + bias[None, :, None, None]
    logits = jnp.where(valid[None, None, None], logits, NEG_INF)
    m = jnp.max(logits, axis=-1, keepdims=True)
    p = jnp.exp(logits - m)
    s = jnp.sum(p, axis=-1, keepdims=True)
    o = jnp.einsum('bhrnqk,bhrnkd->bhrnqd', p, vv) / s
    lse = (m + jnp.log(s))[..., 0]

    o = o.reshape(Bsz, H, dilation, L, Dh).transpose(0, 1, 3, 2, 4).reshape(Bsz, H, Sp, Dh)[:, :, :S]
    lse = lse.reshape(Bsz, H, dilation, L).transpose(0, 1, 3, 2).reshape(Bsz, H, Sp)[:, :, :S]
    return o, lse


def dilated_mixer(q, k, v, rel_bias):
    Bsz, S, H, Dh = q.shape
    qf, kf, vf = (t.astype(jnp.float32).transpose(0, 2, 1, 3) for t in (q, k, v))
    outs, lses = [], []
    for window, dilation in DIL_PATTERNS:
        o, lse = dilated_branch(qf, kf, vf, rel_bias, window, dilation)
        outs.append(o)
        lses.append(lse)
    w = jax.nn.softmax(jnp.stack(lses, axis=0), axis=0)
    o = jnp.sum(w[..., None] * jnp.stack(outs, axis=0), axis=0)
    return o.transpose(0, 2, 1, 3).reshape(Bsz, S, H * Dh)


def setup_inputs(seed: int = 0) -> dict:
    key = jax.random.key(seed)
    ks = jax.random.split(key, 16)
    f32 = jnp.float32
    nrm = lambda k, shape, scale: jax.random.normal(k, shape, f32) * scale
    return {
        "x": nrm(ks[0], (BATCH, SEQ, D_MODEL), 1.0),
        "norm1_g": 1.0 + nrm(ks[1], (DEPTH, D_MODEL), 0.02),
        "w_in": nrm(ks[2], (DEPTH, D_MODEL, N_IN), D_MODEL ** -0.5),
        "gla_gate_w2": nrm(ks[3], (DEPTH, GLA_GATE_RANK, GLA_HEADS * GLA_DK), GLA_GATE_RANK ** -0.5),
        "gla_gate_b": nrm(ks[4], (DEPTH, GLA_HEADS * GLA_DK), 0.1),
        "gla_onorm_g": 1.0 + nrm(ks[5], (DEPTH, GLA_DV), 0.02),
        "q_norm_g": 1.0 + nrm(ks[6], (DEPTH, DIL_DH), 0.02),
        "k_norm_g": 1.0 + nrm(ks[7], (DEPTH, DIL_DH), 0.02),
        "rel_bias": nrm(ks[8], (REL_BUCKETS, DIL_HEADS), 0.5),
        "w_out": nrm(ks[9], (DEPTH, MIX_WIDTH, D_MODEL), MIX_WIDTH ** -0.5),
        "norm2_g": 1.0 + nrm(ks[10], (DEPTH, D_MODEL), 0.02),
        "w_gate": nrm(ks[11], (DEPTH, D_MODEL, FFN_HIDDEN), D_MODEL ** -0.5),
        "w_up": nrm(ks[12], (DEPTH, D_MODEL, FFN_HIDDEN), D_MODEL ** -0.5),
        "w_down": nrm(ks[13], (DEPTH, FFN_HIDDEN, D_MODEL), FFN_HIDDEN ** -0.5),
    }


def reference(x, norm1_g, w_in, gla_gate_w2, gla_gate_b, gla_onorm_g, q_norm_g, k_norm_g,
              rel_bias, w_out, norm2_g, w_gate, w_up, w_down):
    Bsz, S, _ = x.shape
    split_points = list(np.cumsum(SPLIT_SIZES)[:-1])
    for l in range(DEPTH):
        h = rms_norm(x, norm1_g[l])
        proj = h @ w_in[l]
        qa, ka, va, ra, ga, qb, kb, vb = jnp.split(proj, split_points, axis=-1)
        gate_pre = (ga @ gla_gate_w2[l] + gla_gate_b[l]).astype(jnp.float32)
        log_g = jax.nn.log_sigmoid(gate_pre) / GLA_GATE_TAU
        out_a = gla_mixer(qa.reshape(Bsz, S, GLA_HEADS, GLA_DK),
                          ka.reshape(Bsz, S, GLA_HEADS, GLA_DK),
                          va.reshape(Bsz, S, GLA_HEADS, GLA_DV),
                          ra,
                          log_g.reshape(Bsz, S, GLA_HEADS, GLA_DK),
                          gla_onorm_g[l])
        qb = rms_norm(qb.reshape(Bsz, S, DIL_HEADS, DIL_DH), q_norm_g[l])
        kb = rms_norm(kb.reshape(Bsz, S, DIL_HEADS, DIL_DH), k_norm_g[l])
        out_b = dilated_mixer(qb, kb, vb.reshape(Bsz, S, DIL_HEADS, DIL_DH), rel_bias)
        mix = jnp.concatenate([out_a.astype(x.dtype), out_b.astype(x.dtype)], axis=-1)
        x = x + mix @ w_out[l]
        h2 = rms_norm(x, norm2_g[l])
        x = x + (jax.nn.silu(h2 @ w_gate[l]) * (h2 @ w_up[l])) @ w_down[l]
    return x
```

```cpp
#include <hip/hip_runtime.h>
#include <cstdio>
#include <cstdint>
namespace pg8 {
#define PG8_LAS __attribute__((address_space(3)))
typedef unsigned short bf16_t;
typedef short bf16x8 __attribute__((ext_vector_type(8)));
typedef float f32x4 __attribute__((ext_vector_type(4)));
typedef unsigned u32x4 __attribute__((ext_vector_type(4)));
constexpr int BM = 256, BK = 64, HALF = 128, HTB = HALF * BK * 2  , STAGE_BYTES = 8 * HTB, NXCD = 8, WGM = 8;

__host__ __device__ __forceinline__ int lds_byte(int r, int c) { const int st = (r >> 4) * 2 + (c >> 5), rr = r & 15, cc = c & 31, ob = rr * 64 + cc * 2; return st * 1024 + (ob ^ (((ob >> 9) & 1) << 5)); }
__host__ __device__ __forceinline__ void stage_rc(int b, int& R, int& C) { const int st = b / 1024, sb = b % 1024, swz = sb ^ (((sb >> 9) & 1) << 5); R = (st >> 1) * 16 + swz / 64; C = (st & 1) * 32 + (swz % 64) / 2; }
__host__ __device__ __forceinline__ int perm32(int rho) { const int n = rho >> 4, i = rho & 15; return 8 * (i >> 2) + 4 * n + (i & 3); }

struct Unit { int pm, pn; };
struct Gemm { const bf16_t* A; const bf16_t* Bt; int M, N, K; };

struct StaticOrder {
    int nM, nN, nwg, G, c;
    __host__ __device__ void init(int M, int N, int G_, int c_) { nM = M / BM; nN = N / BM; nwg = nM * nN; G = G_; c = c_; }
    __host__ __device__ bool next(int i, Unit& u) const {
        const long L = (long)i * G + c; if (L >= nwg) return false;
        int wgid = (int)L; { const int q = nwg / NXCD, r = nwg % NXCD, xcd = wgid % NXCD, off = wgid / NXCD; wgid = (xcd < r ? xcd * (q + 1) : r * (q + 1) + (xcd - r) * q) + off; }
        const int nig = WGM * nN, gid = wgid / nig, fm = gid * WGM, gsz = (nM - fm) < WGM ? (nM - fm) : WGM;
        u.pm = fm + ((wgid % nig) % gsz); u.pn = (wgid % nig) / gsz; return true;
    }
    __device__ __forceinline__ void a_ready(const Unit&) const {}
    __device__ __forceinline__ void done(const Unit&) const {}
};

__device__ __forceinline__ unsigned cvt_pk_bf16(float lo, float hi) { unsigned r; asm volatile("v_cvt_pk_bf16_f32 %0, %1, %2" : "=v"(r) : "v"(lo), "v"(hi)); return r; }
typedef float f32x2 __attribute__((ext_vector_type(2)));

template <int ACT> struct EpiBf16 {
    static constexpr bool PERM = true, AFTER_DRAIN = false;
    bf16_t* O; int ldc;
    __device__ __forceinline__ void operator()(const f32x4 (&acc)[2][2][4][2], const Unit& u, int wr, int wc, int fr, int fq) const {
        const int row0 = u.pm * BM + wr * 64 + fr; const int col0 = u.pn * BM + wc * 32 + 8 * fq;
#pragma unroll
        for (int ai = 0; ai < 2; ++ai)
#pragma unroll
            for (int m = 0; m < 4; ++m) { bf16_t* rowp = O + (size_t)(row0 + ai * HALF + m * 16) * ldc + col0;
#pragma unroll
                for (int bj = 0; bj < 2; ++bj) { const f32x4 v0 = acc[ai][bj][m][0], v1 = acc[ai][bj][m][1];
                    u32x4 w; w.x = cvt_pk_bf16(v0[0], v0[1]); w.y = cvt_pk_bf16(v0[2], v0[3]); w.z = cvt_pk_bf16(v1[0], v1[1]); w.w = cvt_pk_bf16(v1[2], v1[3]);
                    *(u32x4*)(rowp + bj * HALF) = w; } }
    }
};
struct EpiRes {
    static constexpr bool PERM = false, AFTER_DRAIN = false;
    const float* base; float* out; int ldc;
    __device__ __forceinline__ void operator()(const f32x4 (&acc)[2][2][4][2], const Unit& u, int wr, int wc, int fr, int fq) const {
        const int row0 = u.pm * BM + wr * 64 + fr, col0 = u.pn * BM + wc * 32 + 4 * fq;
#pragma unroll
        for (int ai = 0; ai < 2; ++ai)
#pragma unroll
            for (int m = 0; m < 4; ++m) { const size_t off = (size_t)(row0 + ai * HALF + m * 16) * ldc + col0;
#pragma unroll
                for (int bj = 0; bj < 2; ++bj)
#pragma unroll
                    for (int n = 0; n < 2; ++n) { const f32x4 b = *(const f32x4*)(base + off + bj * HALF + n * 16); *(f32x4*)(out + off + bj * HALF + n * 16) = b + acc[ai][bj][m][n]; }
                asm volatile("" ::: "memory"); }
    }
};
struct EpiSwiglu {
    static constexpr bool PERM = true, AFTER_DRAIN = false;
    bf16_t* O; int ldh;
    __device__ __forceinline__ void operator()(const f32x4 (&acc)[2][2][4][2], const Unit& u, int wr, int wc, int fr, int fq) const {
        typedef unsigned u32x2v __attribute__((ext_vector_type(2)));
        const int row0 = u.pm * BM + wr * 64 + fr; const int h0 = u.pn * 128 + wc * 16 + 4 * fq;
#pragma unroll
        for (int ai = 0; ai < 2; ++ai)
#pragma unroll
            for (int m = 0; m < 4; ++m) { bf16_t* rowp = O + (size_t)(row0 + ai * HALF + m * 16) * ldh + h0;
#pragma unroll
                for (int bj = 0; bj < 2; ++bj) { const f32x4 g = acc[ai][bj][m][0], up = acc[ai][bj][m][1]; float v[4];
#pragma unroll
                    for (int e = 0; e < 4; ++e) v[e] = g[e] * __builtin_amdgcn_rcpf(1.0f + __expf(-g[e])) * up[e];
                    u32x2v w; w.x = cvt_pk_bf16(v[0], v[1]); w.y = cvt_pk_bf16(v[2], v[3]);
                    *(u32x2v*)(rowp + bj * 64) = w; } }
    }
};
template <class Epi, class Sched, bool ALIGN_EPI = false, bool SP2 = false>
__device__ __forceinline__ void gemm_phase(PG8_LAS unsigned char* lds, const Gemm g, const Sched& S, const Epi& E) {
    const int tid = threadIdx.x, wid = __builtin_amdgcn_readfirstlane(tid >> 6), lane = tid & 63, wr = wid >> 2, wc = wid & 3, fr = lane & 15, fq = lane >> 4;
    const int K = g.K, nt = K / BK;
    unsigned voffA[2], voffB[2];
#pragma unroll
    for (int i = 0; i < 2; ++i) { int R, C; stage_rc(tid * 16 + i * 8192, R, C); const int Rb = Epi::PERM ? ((R & ~31) + perm32(R & 31)) : R;
        voffA[i] = (unsigned)(R * K + C) * 2u; voffB[i] = (unsigned)(Rb * K + C) * 2u; }
    const size_t kstep = (size_t)(BK * 2);
    const size_t hstep = (size_t)HALF * K * 2;
    const size_t tstep = 2 * hstep;
    const unsigned ldsw = (unsigned)wid * 1024u;
    const int aoff = lds_byte(wr * 64 + fr, fq * 8), boff = lds_byte(wc * 32 + fr, fq * 8);
#define PG8_SA(b, h) (((b) * 2 + (h)) * HTB)
#define PG8_SB(b, h) ((4 + (b) * 2 + (h)) * HTB)
#define PG8_STAGE(bufoff, gbase, voff) do { _Pragma("unroll") for (int _i = 0; _i < 2; ++_i) \
        __builtin_amdgcn_global_load_lds((const unsigned*)((const char*)(gbase) + (voff)[_i]), (PG8_LAS unsigned*)(lds + (bufoff) + ldsw + _i * 8192), 16, 0, 0); } while (0)
#define PG8_LDA(dst, b, h) do { _Pragma("unroll") for (int m = 0; m < 4; ++m) _Pragma("unroll") for (int k = 0; k < 2; ++k) dst[m][k] = *(const PG8_LAS bf16x8*)(lds + PG8_SA(b, h) + aoff + m * 2048 + k * 1024); } while (0)
#define PG8_LDB(dst, b, h) do { _Pragma("unroll") for (int n = 0; n < 2; ++n) _Pragma("unroll") for (int k = 0; k < 2; ++k) dst[n][k] = *(const PG8_LAS bf16x8*)(lds + PG8_SB(b, h) + boff + n * 2048 + k * 1024); } while (0)
#define PG8_MMA(ai, bj, At, Bt) do { __builtin_amdgcn_s_setprio(1); _Pragma("unroll") for (int m = 0; m < 4; ++m) _Pragma("unroll") for (int n = 0; n < 2; ++n) _Pragma("unroll") for (int k = 0; k < 2; ++k) \
        acc[ai][bj][m][n] = __builtin_amdgcn_mfma_f32_16x16x32_bf16(Bt[n][k], At[m][k], acc[ai][bj][m][n], 0, 0, 0); __builtin_amdgcn_s_setprio(0); } while (0)
#define PG8_WAIT_V(n) asm volatile("s_waitcnt vmcnt(" #n ")" ::: "memory")
#define PG8_WAIT_L(n) asm volatile("s_waitcnt lgkmcnt(" #n ")" ::: "memory")
#define PG8_BAR __builtin_amdgcn_s_barrier()
#define PG8_SCHED __builtin_amdgcn_sched_barrier(0)
    Unit cur, nxt; int ui = 0;
    if (!S.next(0, cur)) return;
    f32x4 acc[2][2][4][2];
#pragma unroll
    for (int a = 0; a < 2; ++a)
#pragma unroll
        for (int b = 0; b < 2; ++b)
#pragma unroll
            for (int m = 0; m < 4; ++m)
#pragma unroll
                for (int n = 0; n < 2; ++n) acc[a][b][m][n] = (f32x4){0.f, 0.f, 0.f, 0.f};
    bf16x8 At[4][2], B0[2][2], B1[2][2];
    const char* cA = (const char*)g.A + (size_t)cur.pm * tstep; const char* cB = (const char*)g.Bt + (size_t)cur.pn * tstep;
    S.a_ready(cur);
    if constexpr (SP2) {
        PG8_STAGE(PG8_SB(0, 0), cB, voffB); PG8_STAGE(PG8_SB(0, 1), cB + hstep, voffB); PG8_STAGE(PG8_SA(0, 0), cA, voffA); PG8_STAGE(PG8_SA(0, 1), cA + hstep, voffA);
        if (wr == 1) PG8_BAR;
        PG8_WAIT_V(2); PG8_BAR;
        PG8_STAGE(PG8_SB(1, 0), cB + kstep, voffB); PG8_STAGE(PG8_SA(1, 0), cA + kstep, voffA); PG8_STAGE(PG8_SB(1, 1), cB + hstep + kstep, voffB);
        PG8_WAIT_V(6); PG8_BAR;
    } else {
        PG8_STAGE(PG8_SB(0, 0), cB, voffB); PG8_STAGE(PG8_SA(0, 0), cA, voffA); PG8_STAGE(PG8_SB(0, 1), cB + hstep, voffB); PG8_STAGE(PG8_SA(0, 1), cA + hstep, voffA);
        if (wr == 1) PG8_BAR;
        PG8_WAIT_V(4); PG8_BAR;
        PG8_STAGE(PG8_SB(1, 0), cB + kstep, voffB); PG8_STAGE(PG8_SA(1, 0), cA + kstep, voffA); PG8_STAGE(PG8_SB(1, 1), cB + hstep + kstep, voffB);
        PG8_WAIT_V(6); PG8_BAR;
    }
    for (;;) {
        const bool has_next = S.next(ui + 1, nxt);
        const char* nA = has_next ? (const char*)g.A + (size_t)nxt.pm * tstep : cA; const char* nB = has_next ? (const char*)g.Bt + (size_t)nxt.pn * tstep : cB;
        for (int t = 0; t < nt; t += 2) {
            const bool last = (t == nt - 2);
            const char* a1 = cA + (size_t)(t + 1) * kstep;
            const char* a2 = last ? nA : cA + (size_t)(t + 2) * kstep; const char* b2 = last ? nB : cB + (size_t)(t + 2) * kstep;
            const char* a3 = a2 + kstep; const char* b3 = b2 + kstep;
            if (last && has_next) S.a_ready(nxt);
            if constexpr (SP2) {
            PG8_LDB(B0, 0, 0); PG8_LDB(B1, 0, 1); PG8_SCHED; PG8_LDA(At, 0, 0); PG8_STAGE(PG8_SA(1, 1), a1 + hstep, voffA);
            PG8_WAIT_V(8); PG8_WAIT_L(0); PG8_BAR; PG8_MMA(0, 0, At, B0); PG8_MMA(0, 1, At, B1); PG8_BAR; PG8_SCHED;
            PG8_LDA(At, 0, 1); PG8_STAGE(PG8_SB(0, 0), b2, voffB); PG8_STAGE(PG8_SB(0, 1), b2 + hstep, voffB); PG8_STAGE(PG8_SA(0, 0), a2, voffA);
            PG8_WAIT_V(8); PG8_WAIT_L(0); PG8_BAR; PG8_MMA(1, 0, At, B0); PG8_MMA(1, 1, At, B1); PG8_BAR; PG8_SCHED;
            PG8_LDB(B0, 1, 0); PG8_LDB(B1, 1, 1); PG8_SCHED; PG8_LDA(At, 1, 0); PG8_STAGE(PG8_SA(0, 1), a2 + hstep, voffA);
            PG8_WAIT_V(8); PG8_WAIT_L(0); PG8_BAR; PG8_MMA(0, 0, At, B0); PG8_MMA(0, 1, At, B1); PG8_BAR; PG8_SCHED;
            PG8_LDA(At, 1, 1); PG8_STAGE(PG8_SB(1, 0), b3, voffB); PG8_STAGE(PG8_SB(1, 1), b3 + hstep, voffB); PG8_STAGE(PG8_SA(1, 0), a3, voffA);
            PG8_WAIT_V(8); PG8_WAIT_L(0); PG8_BAR; PG8_MMA(1, 0, At, B0); PG8_MMA(1, 1, At, B1); PG8_BAR; PG8_SCHED;
            } else {
            PG8_LDB(B0, 0, 0); PG8_SCHED; PG8_LDA(At, 0, 0); PG8_STAGE(PG8_SA(1, 1), a1 + hstep, voffA);
            PG8_WAIT_L(8); PG8_BAR; PG8_WAIT_L(0); PG8_MMA(0, 0, At, B0); PG8_BAR; PG8_SCHED;
            PG8_LDB(B1, 0, 1); PG8_STAGE(PG8_SB(0, 0), b2, voffB);
            PG8_BAR; PG8_WAIT_L(0); PG8_MMA(0, 1, At, B1); PG8_BAR;
            PG8_LDA(At, 0, 1); PG8_STAGE(PG8_SA(0, 0), a2, voffA);
            PG8_BAR; PG8_WAIT_L(0); PG8_MMA(1, 0, At, B0); PG8_BAR; PG8_SCHED;
            PG8_STAGE(PG8_SB(0, 1), b2 + hstep, voffB);
            PG8_WAIT_V(6); PG8_BAR; PG8_MMA(1, 1, At, B1); PG8_BAR;
            PG8_LDB(B0, 1, 0); PG8_SCHED; PG8_LDA(At, 1, 0); PG8_STAGE(PG8_SA(0, 1), a2 + hstep, voffA);
            PG8_WAIT_L(8); PG8_BAR; PG8_WAIT_L(0); PG8_MMA(0, 0, At, B0); PG8_BAR; PG8_SCHED;
            PG8_LDB(B1, 1, 1); PG8_STAGE(PG8_SB(1, 0), b3, voffB);
            PG8_BAR; PG8_WAIT_L(0); PG8_MMA(0, 1, At, B1); PG8_BAR;
            PG8_LDA(At, 1, 1); PG8_STAGE(PG8_SA(1, 0), a3, voffA);
            PG8_BAR; PG8_WAIT_L(0); PG8_MMA(1, 0, At, B0); PG8_BAR; PG8_SCHED;
            PG8_STAGE(PG8_SB(1, 1), b3 + hstep, voffB);
            PG8_WAIT_V(6); PG8_BAR; PG8_MMA(1, 1, At, B1); PG8_BAR;
            }
        }
        if constexpr (ALIGN_EPI) { if (wr == 0) PG8_BAR; }
        if constexpr (!Epi::AFTER_DRAIN) { E(acc, cur, wr, wc, fr, fq); S.done(cur); }
        if (!has_next) break;
#pragma unroll
        for (int a = 0; a < 2; ++a)
#pragma unroll
            for (int b = 0; b < 2; ++b)
#pragma unroll
                for (int m = 0; m < 4; ++m)
#pragma unroll
                    for (int n = 0; n < 2; ++n) acc[a][b][m][n] = (f32x4){0.f, 0.f, 0.f, 0.f};
        cur = nxt; cA = nA; cB = nB; ++ui;
        if constexpr (ALIGN_EPI) { if (wr == 1) PG8_BAR; }
    }
    PG8_WAIT_V(0);
    if constexpr (!ALIGN_EPI) { if (wr == 0) PG8_BAR; }
    PG8_BAR;
    if constexpr (Epi::AFTER_DRAIN) { E.fused(acc, cur, wr, wc, fr, fq, lds, wid, lane); S.done(cur); }
#undef PG8_SA
#undef PG8_SB
#undef PG8_STAGE
#undef PG8_LDA
#undef PG8_LDB
#undef PG8_MMA
#undef PG8_WAIT_V
#undef PG8_WAIT_L
#undef PG8_BAR
#undef PG8_SCHED
}
}

#define LAS __attribute__((address_space(3)))
typedef unsigned short bf16;
typedef unsigned v4u __attribute__((ext_vector_type(4)));
typedef unsigned v2u __attribute__((ext_vector_type(2)));
typedef float f32x4 __attribute__((ext_vector_type(4)));
constexpr int NWAVES = 8, NTHR = 512;
constexpr int DM = 2048, NB = 4, SEQ = 2048, T = NB * SEQ, DEPTH = 2;
constexpr int NIN = 6160, NPROJ = 6144, FFN = 5632, NGU = 2 * FFN;
constexpr int C_QA = 0, C_KA = 512, C_VA = 1024, C_RA = 2048, C_QB = 3072, C_KB = 4096, C_VB = 5120;
constexpr float RMS_EPS = 1e-6f;
constexpr size_t MiB = 1u << 20;
constexpr size_t WS_WIN = 1 * MiB, WS_WOUT = 49 * MiB, WS_WGU = 65 * MiB, WS_WD = 153 * MiB, WS_XB = 197 * MiB, WS_PROJ = 229 * MiB, WS_HMID = 229 * MiB,
                 WS_GA = 325 * MiB, WS_MIX = 326 * MiB, WS_END = 358 * MiB;
constexpr size_t SZ_WIN = (size_t)NPROJ * DM * 2, SZ_WOUT = (size_t)DM * DM * 2, SZ_WGU = (size_t)NGU * DM * 2, SZ_WD = (size_t)DM * FFN * 2;
static_assert(WS_WIN + 2 * SZ_WIN <= WS_WOUT && WS_WOUT + 2 * SZ_WOUT <= WS_WGU && WS_WGU + 2 * SZ_WGU <= WS_WD && WS_WD + 2 * SZ_WD <= WS_XB, "ws map (weights)");
static_assert(WS_XB + (size_t)T * DM * 2 <= WS_PROJ && WS_PROJ + (size_t)T * NPROJ * 2 <= WS_GA && WS_HMID + (size_t)T * FFN * 2 <= WS_GA && WS_GA + (size_t)T * 16 * 4 <= WS_MIX && WS_MIX + (size_t)T * DM * 2 <= WS_END, "ws map (activations)");
constexpr int LDS_BYTES = 147456;

__device__ const unsigned char kBucket[3][129] = {
 {0,1,2,3,4,5,6,7,8,9,10,11,12,13,14,15,16,16,16,16,16,16,17,17,17,17,17,17,17,17,18,18,18,18,18,18,18,18,18,18,19,19,19,19,19,19,19,19,19,19,19,19,19,19,20,20,20,20,20,20,20,20,20,20,20,20,20,20,20,20,20,20,20,21,21,21,21,21,21,21,21,21,21,21,21,21,21,21,21,21,21,21,21,21,21,21,21,21,21,22,22,22,22,22,22,22,22,22,22,22,22,22,22,22,22,22,22,22,22,22,22,22,22,22,22,22,22,22,22},
 {0,4,8,12,16,16,17,17,18,18,19,19,19,19,20,20,20,20,20,21,21,21,21,21,21,22,22,22,22,22,22,22,22,22,23,23,23,23,23,23,23,23,23,23,23,23,24,24,24,24,24,24,24,24,24,24,24,24,24,24,24,24,25,25,25,25,25,25,25,25,25,25,25,25,25,25,25,25,25,25,25,25,25,26,26,26,26,26,26,26,26,26,26,26,26,26,26,26,26,26,26,26,26,26,26,26,26,26,26,26,26,26,26,27,27,27,27,27,27,27,27,27,27,27,27,27,27,27,27},
 {0,16,18,19,20,21,21,22,22,23,23,23,24,24,24,24,25,25,25,25,25,26,26,26,26,26,26,26,26,27,27,27,27,27,27,27,27,27,27,28,28,28,28,28,28,28,28,28,28,28,28,28,29,29,29,29,29,29,29,29,29,29,29,29,29,29,29,29,29,29,30,30,30,30,30,30,30,30,30,30,30,30,30,30,30,30,30,30,30,30,30,30,30,30,30,31,31,31,31,31,31,31,31,31,31,31,31,31,31,31,31,31,31,31,31,31,31,31,31,31,31,31,31,31,31,31,31,31,31}};

#define LDS_WAIT() asm volatile("s_waitcnt lgkmcnt(0)" ::: "memory")
__device__ __forceinline__ unsigned f2bf(float f) { unsigned u = __builtin_bit_cast(unsigned, f); return (u + 0x7fffu + ((u >> 16) & 1u)) >> 16; }
__device__ __forceinline__ unsigned pk2(float lo, float hi) { return f2bf(lo) | (f2bf(hi) << 16); }
__device__ __forceinline__ float bf2f(unsigned h) { return __builtin_bit_cast(float, h << 16); }
__device__ __forceinline__ float bflo(unsigned w) { return __builtin_bit_cast(float, w << 16); }
__device__ __forceinline__ float bfhi(unsigned w) { return __builtin_bit_cast(float, w & 0xffff0000u); }
__device__ __forceinline__ float wave_sum(float v) {
#pragma unroll
    for (int o = 1; o < 64; o <<= 1) v += __shfl_xor(v, o);
    return v;
}
__device__ __forceinline__ float wave_max(float v) {
#pragma unroll
    for (int o = 1; o < 64; o <<= 1) v = fmaxf(v, __shfl_xor(v, o));
    return v;
}

struct Ctx {
    LAS unsigned char* lds; int tid, lane, wave, G, bid;
    const float *x, *norm1_g, *w_in, *gate_w2, *gate_b, *onorm_g, *qn_g, *kn_g, *rel_bias, *w_out, *norm2_g, *w_gate, *w_up, *w_down;
    float* out; unsigned char* ws;
};

template <class RowMap>
__device__ __forceinline__ void transpose_item(const float* W, int ldw, int srccol0, int k0, bf16* WT, int K, RowMap rm, LAS float* scr, int lane) {
#pragma unroll 8
    for (int i = 0; i < 32; ++i) { const int kk = 2 * i + (lane >> 5); scr[kk * 33 + (lane & 31)] = W[(size_t)(k0 + kk) * ldw + srccol0 + (lane & 31)]; }
    LDS_WAIT();
    const int c = lane & 7;
#pragma unroll
    for (int j = 0; j < 4; ++j) { const int n = (lane >> 3) + 8 * j; const LAS float* s = scr + (8 * c) * 33 + n;
        v4u o; o.x = pk2(s[0 * 33], s[1 * 33]); o.y = pk2(s[2 * 33], s[3 * 33]); o.z = pk2(s[4 * 33], s[5 * 33]); o.w = pk2(s[6 * 33], s[7 * 33]);
        *(v4u*)(WT + (size_t)rm(n) * K + k0 + 8 * c) = o; }
    LDS_WAIT();
}
__device__ __forceinline__ void phase_convert(const Ctx& F) {
    LAS float* scr = (LAS float*)(F.lds + F.wave * 16384);
    const int gw = F.bid * NWAVES + F.wave, NGW = F.G * NWAVES;
    constexpr int I_IN = (DM / 64) * (NPROJ / 32), I_OUT = (DM / 64) * (DM / 32), I_G = (DM / 64) * (FFN / 32), I_D = (FFN / 64) * (DM / 32);
    constexpr int PER_LAYER = I_IN + I_OUT + 2 * I_G + I_D;
    for (int it = gw; it < DEPTH * PER_LAYER; it += NGW) {
        const int l = it / PER_LAYER; int r = it % PER_LAYER;
        if (r < I_IN) { const int nblk = NPROJ / 32, kb = r / nblk, nb = r % nblk, n0 = 32 * nb; const int src0 = n0 + (n0 >= 3072 ? 16 : 0);
            transpose_item(F.w_in + (size_t)l * DM * NIN, NIN, src0, 64 * kb, (bf16*)(F.ws + WS_WIN + l * SZ_WIN), DM, [n0](int j) { return n0 + j; }, scr, F.lane); continue; }
        r -= I_IN;
        if (r < I_OUT) { const int nblk = DM / 32, kb = r / nblk, nb = r % nblk, n0 = 32 * nb;
            transpose_item(F.w_out + (size_t)l * DM * DM, DM, n0, 64 * kb, (bf16*)(F.ws + WS_WOUT + l * SZ_WOUT), DM, [n0](int j) { return n0 + j; }, scr, F.lane); continue; }
        r -= I_OUT;
        if (r < 2 * I_G) { const int up = r >= I_G; if (up) r -= I_G; const int nblk = FFN / 32, kb = r / nblk, nb = r % nblk, n0 = 32 * nb;
            transpose_item((up ? F.w_up : F.w_gate) + (size_t)l * DM * FFN, FFN, n0, 64 * kb, (bf16*)(F.ws + WS_WGU + l * SZ_WGU), DM,
                           [n0, up](int j) { const int h = n0 + j; return (h >> 2) * 8 + (h & 3) + 4 * up; }, scr, F.lane); continue; }
        r -= 2 * I_G;
        { const int nblk = DM / 32, kb = r / nblk, nb = r % nblk, n0 = 32 * nb;
            transpose_item(F.w_down + (size_t)l * FFN * DM, DM, n0, 64 * kb, (bf16*)(F.ws + WS_WD + l * SZ_WD), FFN, [n0](int j) { return n0 + j; }, scr, F.lane); }
    }
}

__device__ __forceinline__ void phase_norm(const Ctx& F, const float* x, const float* g, bf16* xb, const float* wga  , float* ga) {
    const int gw = F.bid * NWAVES + F.wave, NGW = F.G * NWAVES, lane = F.lane;
    for (int m = gw; m < T; m += NGW) {
        const f32x4* xr = (const f32x4*)(x + (size_t)m * DM) + lane;
        f32x4 v[8]; float s = 0.f;
#pragma unroll
        for (int j = 0; j < 8; ++j) { v[j] = xr[64 * j]; s += (v[j].x * v[j].x + v[j].y * v[j].y) + (v[j].z * v[j].z + v[j].w * v[j].w); }
        const float rstd = 1.0f / sqrtf(wave_sum(s) * (1.0f / DM) + RMS_EPS);
        v2u* o8 = (v2u*)(xb + (size_t)m * DM) + lane;
#pragma unroll
        for (int j = 0; j < 8; ++j) { const f32x4 gg = *((const f32x4*)g + lane + 64 * j); v[j] = v[j] * rstd * gg; v2u w; w.x = pk2(v[j].x, v[j].y); w.y = pk2(v[j].z, v[j].w); o8[64 * j] = w; }
        if (wga) {
            float acc[16];
#pragma unroll
            for (int i = 0; i < 16; ++i) acc[i] = 0.f;
#pragma unroll 1
            for (int j = 0; j < 8; ++j) { const f32x4 gg = *((const f32x4*)g + lane + 64 * j); const f32x4 y4 = xr[64 * j] * rstd * gg;
#pragma unroll
                for (int e = 0; e < 4; ++e) { const int k = 256 * j + 4 * lane + e; const f32x4* wp = (const f32x4*)(wga + (size_t)k * NIN + 3072); const float y = y4[e];
#pragma unroll
                    for (int q = 0; q < 4; ++q) { const f32x4 w = wp[q]; acc[4 * q] += y * w.x; acc[4 * q + 1] += y * w.y; acc[4 * q + 2] += y * w.z; acc[4 * q + 3] += y * w.w; } } }
            float outv = 0.f;
#pragma unroll
            for (int i = 0; i < 16; ++i) { const float t = wave_sum(acc[i]); if (lane == i) outv = t; }
            if (lane < 16) ga[(size_t)m * 16 + lane] = outv;
        }
    }
}

__device__ __forceinline__ void phase_qknorm(const Ctx& F, bf16* proj, const float* qg, const float* kg) {
    const int gw = F.bid * NWAVES + F.wave, NGW = F.G * NWAVES, lane = F.lane;
    const float gq0 = qg[2 * lane] * 0.08838834764831845f, gq1 = qg[2 * lane + 1] * 0.08838834764831845f, gk0 = kg[2 * lane], gk1 = kg[2 * lane + 1];
    for (int m = gw; m < T; m += NGW) {
        unsigned* base = (unsigned*)(proj + (size_t)m * NPROJ + C_QB) + lane;
#pragma unroll 4
        for (int hh = 0; hh < 16; ++hh) {
            const unsigned w = base[hh * 64]; const float a = bflo(w), b = bfhi(w);
            const float rstd = 1.0f / sqrtf(wave_sum(a * a + b * b) * (1.0f / 128.0f) + RMS_EPS);
            base[hh * 64] = hh < 8 ? pk2(a * rstd * gq0, b * rstd * gq1) : pk2(a * rstd * gk0, b * rstd * gk1);
        }
    }
}

__device__ __forceinline__ void gla_naive(const Ctx& F, int bh, const bf16* proj, const float* ga, const float* w2, const float* gb, const float* gon, bf16* mix) {
    const int b = bh >> 2, h = bh & 3, tid = F.tid, c = tid & 255, hh = tid >> 8, lane = F.lane, wave = F.wave;
    LAS float* dec = (LAS float*)F.lds;
    LAS float* qs = dec + 2048;
    LAS float* ks = qs + 2048;
    LAS float* op = ks + 2048;
    LAS float* red = op + 8192;
    float S[64];
#pragma unroll
    for (int d = 0; d < 64; ++d) S[d] = 0.f;
    const float gonc = gon[c];
    for (int t0 = 0; t0 < SEQ; t0 += 16) {
#pragma unroll
        for (int e = 0; e < 4; ++e) { const int idx = tid + 512 * e, s = idx >> 7, dk = idx & 127; const size_t m = (size_t)b * SEQ + t0 + s;
            float gp = gb[h * 128 + dk];
#pragma unroll
            for (int j = 0; j < 16; ++j) gp += ga[m * 16 + j] * w2[j * 512 + h * 128 + dk];
            const float lgv = (fminf(gp, 0.f) - log1pf(expf(-fabsf(gp)))) * (1.0f / 16.0f);
            dec[idx] = expf(lgv); qs[idx] = bf2f(proj[m * NPROJ + C_QA + h * 128 + dk]) * 0.08838834764831845f; ks[idx] = bf2f(proj[m * NPROJ + C_KA + h * 128 + dk]); }
        __syncthreads();
#pragma unroll 1
        for (int s = 0; s < 16; ++s) { const size_t m = (size_t)b * SEQ + t0 + s; const float v = bf2f(proj[m * NPROJ + C_VA + h * 256 + c]); float acc = 0.f;
            const LAS float* dp = dec + s * 128 + 64 * hh; const LAS float* kp = ks + s * 128 + 64 * hh; const LAS float* qp = qs + s * 128 + 64 * hh;
#pragma unroll
            for (int d4 = 0; d4 < 16; ++d4) { const f32x4 dd = *(const LAS f32x4*)(dp + 4 * d4), kk = *(const LAS f32x4*)(kp + 4 * d4), qq = *(const LAS f32x4*)(qp + 4 * d4);
#pragma unroll
                for (int e = 0; e < 4; ++e) { S[4 * d4 + e] = dd[e] * S[4 * d4 + e] + kk[e] * v; acc += qq[e] * S[4 * d4 + e]; }
                if ((d4 & 3) == 3) asm volatile("" ::: "memory"); }
            op[(hh * 16 + s) * 256 + c] = acc; }
        __syncthreads();
        float of[8];
#pragma unroll
        for (int i = 0; i < 8; ++i) { const int s = 8 * hh + i; of[i] = op[s * 256 + c] + op[(16 + s) * 256 + c]; const float ss = wave_sum(of[i] * of[i]); if (lane == 0) red[s * 4 + (wave & 3)] = ss; }
        __syncthreads();
#pragma unroll
        for (int i = 0; i < 8; ++i) { const int s = 8 * hh + i; const size_t m = (size_t)b * SEQ + t0 + s;
            const float tot = (red[s * 4] + red[s * 4 + 1]) + (red[s * 4 + 2] + red[s * 4 + 3]); const float rstd = 1.0f / sqrtf(tot * (1.0f / 256.0f) + RMS_EPS);
            const float r = bf2f(proj[m * NPROJ + C_RA + h * 256 + c]); const float y = of[i] * rstd * gonc * (r / (1.0f + expf(-r)));
            mix[m * DM + h * 256 + c] = (bf16)f2bf(y); }
    }
}

__device__ __forceinline__ void attn_naive(const Ctx& F, int aw, int naw, const bf16* proj, const float* rel_bias, bf16* mix) {
    const int lane = F.lane;
    LAS float* qs = (LAS float*)(F.lds + 65536 + F.wave * 4096);
    LAS float* ps = qs + 128;
    LAS int* toks = (LAS int*)(ps + 448);
    for (int item = aw; item < T * 8; item += naw) {
        const int m = item >> 3, h = item & 7, b = m >> 11, t = m & 2047;
        { const unsigned w = *((const unsigned*)(proj + (size_t)m * NPROJ + C_QB + h * 128) + lane); qs[2 * lane] = bflo(w); qs[2 * lane + 1] = bfhi(w); }
        LDS_WAIT();
        float lg[7]; int tk[7]; float mx = -INFINITY;
#pragma unroll
        for (int i = 0; i < 7; ++i) { const int idx = lane + 64 * i; const int br = idx < 129 ? 0 : (idx < 258 ? 1 : 2); const int k = idx - 129 * br; const int tkn = t - (k << (2 * br));
            const bool valid = idx < 387 && tkn >= 0; tk[i] = valid ? tkn : 0; float dot = 0.f;
            if (valid) { const v4u* kr = (const v4u*)(proj + ((size_t)b * SEQ + tkn) * NPROJ + C_KB + h * 128);
#pragma unroll 4
                for (int c8 = 0; c8 < 16; ++c8) { const v4u w = kr[c8]; const LAS float* q = qs + 8 * c8;
                    dot += q[0] * bflo(w.x) + q[1] * bfhi(w.x) + q[2] * bflo(w.y) + q[3] * bfhi(w.y) + q[4] * bflo(w.z) + q[5] * bfhi(w.z) + q[6] * bflo(w.w) + q[7] * bfhi(w.w); }
                dot += rel_bias[kBucket[br][k] * 8 + h]; }
            lg[i] = valid ? dot : -INFINITY; mx = fmaxf(mx, lg[i]); }
        mx = wave_max(mx); float l = 0.f;
#pragma unroll
        for (int i = 0; i < 7; ++i) { const float p = (lg[i] == -INFINITY) ? 0.f : expf(lg[i] - mx); l += p; ps[lane + 64 * i] = p; toks[lane + 64 * i] = tk[i]; }
        l = wave_sum(l);
        LDS_WAIT();
        float a0 = 0.f, a1 = 0.f;
        const unsigned* vb = (const unsigned*)(proj + (size_t)b * SEQ * NPROJ + C_VB + h * 128) + lane;
        for (int idx = 0; idx < 387; ++idx) { const float p = ps[idx]; const int tkn = toks[idx]; const unsigned w = vb[(size_t)tkn * (NPROJ / 2)]; a0 += p * bflo(w); a1 += p * bfhi(w); }
        const float inv = 1.0f / l;
        *((unsigned*)(mix + (size_t)m * DM + 1024 + h * 128) + lane) = pk2(a0 * inv, a1 * inv);
        LDS_WAIT();
    }
}

constexpr int NPHASE = 1 + 8 * DEPTH;
struct Args { const float* in[14]; float* out; unsigned char* ws; int ph_lo, ph_hi; };
#define PH_IN(k) (lo <= (k) && (k) < hi)
#define PH_END(k) do { } while (0)
template <int L> __device__ __forceinline__ void layer_phases(const Ctx& F, const int lo, const int hi) {
    constexpr int P0 = 1 + 8 * L;
    bf16* XB = (bf16*)(F.ws + WS_XB); bf16* PROJ = (bf16*)(F.ws + WS_PROJ); bf16* HMID = (bf16*)(F.ws + WS_HMID); float* GA = (float*)(F.ws + WS_GA); bf16* MIX = (bf16*)(F.ws + WS_MIX);
    const float* xin = (L == 0) ? F.x : F.out;
    if (PH_IN(P0 + 0)) { phase_norm(F, xin, F.norm1_g + L * DM, XB, F.w_in + (size_t)L * DM * NIN, GA); PH_END(P0 + 0); }
    if (PH_IN(P0 + 1)) {
        pg8::Gemm g{XB, (const bf16*)(F.ws + WS_WIN + L * SZ_WIN), T, NPROJ, DM}; pg8::StaticOrder S; S.init(T, NPROJ, F.G, F.bid);
        pg8::EpiBf16<0> E{PROJ, NPROJ};
        pg8::gemm_phase<pg8::EpiBf16<0>, pg8::StaticOrder, true, true>(F.lds, g, S, E); PH_END(P0 + 1); }
    if (PH_IN(P0 + 2)) { phase_qknorm(F, PROJ, F.qn_g + L * 128, F.kn_g + L * 128); PH_END(P0 + 2); }
    if (PH_IN(P0 + 3)) {
        if (F.bid < 16) gla_naive(F, F.bid, PROJ, GA, F.gate_w2 + L * 16 * 512, F.gate_b + L * 512, F.onorm_g + L * 256, MIX);
        else attn_naive(F, (F.bid - 16) * NWAVES + F.wave, (F.G - 16) * NWAVES, PROJ, F.rel_bias, MIX);
        PH_END(P0 + 3); }
    if (PH_IN(P0 + 4)) {
        pg8::Gemm g{MIX, (const bf16*)(F.ws + WS_WOUT + L * SZ_WOUT), T, DM, DM}; pg8::StaticOrder S; S.init(T, DM, F.G, F.bid);
        pg8::EpiRes E{xin, F.out, DM};
        pg8::gemm_phase<pg8::EpiRes, pg8::StaticOrder, true, true>(F.lds, g, S, E); PH_END(P0 + 4); }
    if (PH_IN(P0 + 5)) { phase_norm(F, F.out, F.norm2_g + L * DM, XB, nullptr, nullptr); PH_END(P0 + 5); }
    if (PH_IN(P0 + 6)) {
        pg8::Gemm g{XB, (const bf16*)(F.ws + WS_WGU + L * SZ_WGU), T, NGU, DM}; pg8::StaticOrder S; S.init(T, NGU, F.G, F.bid);
        pg8::EpiSwiglu E{HMID, FFN};
        pg8::gemm_phase<pg8::EpiSwiglu, pg8::StaticOrder, true, true>(F.lds, g, S, E); PH_END(P0 + 6); }
    if (PH_IN(P0 + 7)) {
        pg8::Gemm g{HMID, (const bf16*)(F.ws + WS_WD + L * SZ_WD), T, DM, FFN}; pg8::StaticOrder S; S.init(T, DM, F.G, F.bid);
        pg8::EpiRes E{F.out, F.out, DM};
        pg8::gemm_phase<pg8::EpiRes, pg8::StaticOrder, true, true>(F.lds, g, S, E); PH_END(P0 + 7); }
}
__global__ void __launch_bounds__(NTHR, 2) fwd(Args a) {
    extern __shared__ __attribute__((aligned(16))) unsigned char lds_raw[];
    Ctx F;
    F.lds = (LAS unsigned char*)lds_raw; F.tid = threadIdx.x; F.lane = F.tid & 63; F.wave = __builtin_amdgcn_readfirstlane(F.tid >> 6); F.G = gridDim.x; F.bid = blockIdx.x;
    F.x = a.in[0]; F.norm1_g = a.in[1]; F.w_in = a.in[2]; F.gate_w2 = a.in[3]; F.gate_b = a.in[4]; F.onorm_g = a.in[5]; F.qn_g = a.in[6]; F.kn_g = a.in[7]; F.rel_bias = a.in[8];
    F.w_out = a.in[9]; F.norm2_g = a.in[10]; F.w_gate = a.in[11]; F.w_up = a.in[12]; F.w_down = a.in[13]; F.out = a.out; F.ws = a.ws;
    const int lo = a.ph_lo, hi = a.ph_hi;
    if (PH_IN(0)) { phase_convert(F); PH_END(0); }
    layer_phases<0>(F, lo, hi);
    layer_phases<1>(F, lo, hi);
}

extern "C" void kernel_launch(void* const* d_in, const int* in_sizes, int n_in, void* d_out, int out_size, void* d_ws, size_t ws_size, hipStream_t stream) {
    static int grid = 0;
    if (grid == 0) {
        if (n_in != 14 || out_size != T * DM || ws_size < WS_END) { fprintf(stderr, "kernel_launch: unexpected shapes (n_in %d, out %d, ws %zu)\n", n_in, out_size, ws_size); grid = -1; return; }
        if (hipFuncSetAttribute((const void*)fwd, hipFuncAttributeMaxDynamicSharedMemorySize, LDS_BYTES) != hipSuccess) { fprintf(stderr, "kernel_launch: hipFuncSetAttribute failed\n"); grid = -1; return; }
        grid = 256;
    }
    if (grid < 0) return;
    Args a{};
    for (int i = 0; i < 14; ++i) a.in[i] = (const float*)d_in[i];
    a.out = (float*)d_out; a.ws = (unsigned char*)d_ws;
    for (int ph = 0; ph < NPHASE; ++ph) { a.ph_lo = ph; a.ph_hi = ph + 1; hipLaunchKernelGGL(fwd, dim3(grid), dim3(NTHR), LDS_BYTES, stream, a); }
}
```

```cpp
#define CODE_SHIFT_NOPS 28
#define CODE_SHIFT_STR "28"
#include <hip/hip_runtime.h>
#include <hip/hip_cooperative_groups.h>
namespace cg = cooperative_groups;
#include <cstdio>
#include <cstdint>
namespace pg8 {
#define PG8_LAS __attribute__((address_space(3)))
typedef unsigned short bf16_t;
typedef short bf16x8 __attribute__((ext_vector_type(8)));
typedef float f32x4 __attribute__((ext_vector_type(4)));
typedef unsigned u32x4 __attribute__((ext_vector_type(4)));
constexpr int BM = 256, BK = 64, HALF = 128, HTB = HALF * BK * 2  , STAGE_BYTES = 8 * HTB, NXCD = 8, WGM = 8;

__host__ __device__ __forceinline__ int lds_byte(int r, int c) { const int st = (r >> 4) * 2 + (c >> 5), rr = r & 15, cc = c & 31, ob = rr * 64 + cc * 2; return st * 1024 + (ob ^ (((ob >> 9) & 1) << 5)); }
__host__ __device__ __forceinline__ void stage_rc(int b, int& R, int& C) { const int st = b / 1024, sb = b % 1024, swz = sb ^ (((sb >> 9) & 1) << 5); R = (st >> 1) * 16 + swz / 64; C = (st & 1) * 32 + (swz % 64) / 2; }
__host__ __device__ __forceinline__ int perm32(int rho) { const int n = rho >> 4, i = rho & 15; return 8 * (i >> 2) + 4 * n + (i & 3); }

struct Unit { int pm, pn; };
struct Gemm { const bf16_t* A; const bf16_t* Bt; int M, N, K; };

struct StaticOrder {
    int nM, nN, nwg, G, c;
    __host__ __device__ void init(int M, int N, int G_, int c_) { nM = M / BM; nN = N / BM; nwg = nM * nN; G = G_; c = c_; }
    __host__ __device__ bool next(int i, Unit& u) const {
        const long L = (long)i * G + c; if (L >= nwg) return false;
        int wgid = (int)L; { const int q = nwg / NXCD, r = nwg % NXCD, xcd = wgid % NXCD, off = wgid / NXCD; wgid = (xcd < r ? xcd * (q + 1) : r * (q + 1) + (xcd - r) * q) + off; }
        const int nig = WGM * nN, gid = wgid / nig, fm = gid * WGM, gsz = (nM - fm) < WGM ? (nM - fm) : WGM;
        u.pm = fm + ((wgid % nig) % gsz); u.pn = (wgid % nig) / gsz; return true;
    }
    __device__ __forceinline__ void a_ready(const Unit&) const {}
    __device__ __forceinline__ void done(const Unit&) const {}
};

__device__ __forceinline__ unsigned cvt_pk_bf16(float lo, float hi) { unsigned r; asm volatile("v_cvt_pk_bf16_f32 %0, %1, %2" : "=v"(r) : "v"(lo), "v"(hi)); return r; }
typedef float f32x2 __attribute__((ext_vector_type(2)));

template <int ACT> struct EpiBf16 {
    static constexpr bool PERM = true, AFTER_DRAIN = false;
    bf16_t* O; int ldc; const float* ssq; int qk_lo, qk_mid, qk_hi; const float* gq; const float* gk; float qscale; PG8_LAS float* xl; bf16_t* att; int att_rows;
    __device__ __forceinline__ void operator()(const f32x4 (&acc)[2][2][4][2], const Unit& u, int wr, int wc, int fr, int fq) const {
        const int row0 = u.pm * BM + wr * 64 + fr; const int col0 = u.pn * BM + wc * 32 + 8 * fq;
        const bool qk = u.pn >= qk_lo && u.pn < qk_hi;
        float rsr[2][4];
#pragma unroll
        for (int ai = 0; ai < 2; ++ai)
#pragma unroll
            for (int m = 0; m < 4; ++m) rsr[ai][m] = 1.0f / sqrtf(ssq[row0 + ai * HALF + m * 16] * (1.0f / 2048.0f) + 1e-6f);
        f32x4 g0 = {1.f, 1.f, 1.f, 1.f}, g1 = {1.f, 1.f, 1.f, 1.f};
        if (qk) {
            const float* gp = (u.pn < qk_mid ? gq : gk) + wc * 32 + 8 * fq; const float sc = u.pn < qk_mid ? qscale : 1.0f;
            g0 = *(const f32x4*)gp * sc; g1 = *(const f32x4*)(gp + 4) * sc;
#pragma unroll
            for (int ai = 0; ai < 2; ++ai)
#pragma unroll
                for (int m = 0; m < 4; ++m)
#pragma unroll
                    for (int bj = 0; bj < 2; ++bj) { const f32x4 v0 = acc[ai][bj][m][0] * rsr[ai][m], v1 = acc[ai][bj][m][1] * rsr[ai][m];
                        float s = ((v0[0] * v0[0] + v0[1] * v0[1]) + (v0[2] * v0[2] + v0[3] * v0[3])) + ((v1[0] * v1[0] + v1[1] * v1[1]) + (v1[2] * v1[2] + v1[3] * v1[3]));
                        s += __shfl_xor(s, 16); s += __shfl_xor(s, 32);
                        if (fq == 0) xl[((((wr * 2 + ai) * 4 + m) * 2 + bj) * 16 + fr) * 4 + wc] = s; }
            asm volatile("s_waitcnt lgkmcnt(0)" ::: "memory"); __builtin_amdgcn_s_barrier(); asm volatile("" ::: "memory");
        }
#pragma unroll
        for (int ai = 0; ai < 2; ++ai)
#pragma unroll
            for (int m = 0; m < 4; ++m) { const int row = row0 + ai * HALF + m * 16;
                bf16_t* rowp = u.pn < qk_lo ? O + (size_t)row * ldc + col0 : att + ((size_t)(2 * (u.pn - qk_lo)) * att_rows + row) * 128 + wc * 32 + 8 * fq;
                const size_t hstride = u.pn < qk_lo ? (size_t)HALF : (size_t)att_rows * 128;
#pragma unroll
                for (int bj = 0; bj < 2; ++bj) { float rs = rsr[ai][m];
                    if (qk) { const f32x4 p = *(const PG8_LAS f32x4*)(xl + ((((wr * 2 + ai) * 4 + m) * 2 + bj) * 16 + fr) * 4); rs *= 1.0f / sqrtf(((p[0] + p[1]) + (p[2] + p[3])) * (1.0f / 128.0f) + 1e-6f); }
                    const f32x4 v0 = acc[ai][bj][m][0] * rs * g0, v1 = acc[ai][bj][m][1] * rs * g1;
                    u32x4 w; w.x = cvt_pk_bf16(v0[0], v0[1]); w.y = cvt_pk_bf16(v0[2], v0[3]); w.z = cvt_pk_bf16(v1[0], v1[1]); w.w = cvt_pk_bf16(v1[2], v1[3]);
                    *(u32x4*)(rowp + bj * hstride) = w; } }
    }
};
template <bool BASE_F32> struct EpiResB {
    static constexpr bool PERM = true, AFTER_DRAIN = false;
    const float* basf; const bf16_t* basb; bf16_t* xb; int ldc; float* ssq;
    __device__ __forceinline__ void operator()(const f32x4 (&acc)[2][2][4][2], const Unit& u, int wr, int wc, int fr, int fq) const {
        const int row0 = u.pm * BM + wr * 64 + fr, col0 = u.pn * BM + wc * 32 + 8 * fq;
#pragma unroll
        for (int ai = 0; ai < 2; ++ai)
#pragma unroll
            for (int m = 0; m < 4; ++m) { const int row = row0 + ai * HALF + m * 16; const size_t off = (size_t)row * ldc + col0; float ss = 0.f;
#pragma unroll
                for (int bj = 0; bj < 2; ++bj) { f32x4 o0, o1;
                    if (BASE_F32) { o0 = *(const f32x4*)(basf + off + bj * HALF) + acc[ai][bj][m][0]; o1 = *(const f32x4*)(basf + off + bj * HALF + 4) + acc[ai][bj][m][1]; }
                    else { const u32x4 bw = *(const u32x4*)(basb + off + bj * HALF);
                        o0 = (f32x4){__builtin_bit_cast(float, bw.x << 16), __builtin_bit_cast(float, bw.x & 0xffff0000u), __builtin_bit_cast(float, bw.y << 16), __builtin_bit_cast(float, bw.y & 0xffff0000u)} + acc[ai][bj][m][0];
                        o1 = (f32x4){__builtin_bit_cast(float, bw.z << 16), __builtin_bit_cast(float, bw.z & 0xffff0000u), __builtin_bit_cast(float, bw.w << 16), __builtin_bit_cast(float, bw.w & 0xffff0000u)} + acc[ai][bj][m][1]; }
                    ss += ((o0[0] * o0[0] + o0[1] * o0[1]) + (o0[2] * o0[2] + o0[3] * o0[3])) + ((o1[0] * o1[0] + o1[1] * o1[1]) + (o1[2] * o1[2] + o1[3] * o1[3]));
                    u32x4 w; w.x = cvt_pk_bf16(o0[0], o0[1]); w.y = cvt_pk_bf16(o0[2], o0[3]); w.z = cvt_pk_bf16(o1[0], o1[1]); w.w = cvt_pk_bf16(o1[2], o1[3]);
                    *(u32x4*)(xb + off + bj * HALF) = w; }
                ss += __shfl_xor(ss, 16); ss += __shfl_xor(ss, 32);
                if (fq == 0) atomicAdd(ssq + row, ss);
                asm volatile("" ::: "memory"); }
    }
};
struct EpiResF {
    static constexpr bool PERM = false, AFTER_DRAIN = false;
    const bf16_t* basb; float* out; int ldc;
    __device__ __forceinline__ void operator()(const f32x4 (&acc)[2][2][4][2], const Unit& u, int wr, int wc, int fr, int fq) const {
        typedef unsigned u32x2v __attribute__((ext_vector_type(2)));
        const int row0 = u.pm * BM + wr * 64 + fr, col0 = u.pn * BM + wc * 32 + 4 * fq;
#pragma unroll
        for (int ai = 0; ai < 2; ++ai)
#pragma unroll
            for (int m = 0; m < 4; ++m) { const size_t off = (size_t)(row0 + ai * HALF + m * 16) * ldc + col0;
#pragma unroll
                for (int bj = 0; bj < 2; ++bj)
#pragma unroll
                    for (int n = 0; n < 2; ++n) { const u32x2v bw = *(const u32x2v*)(basb + off + bj * HALF + n * 16);
                        const f32x4 b = {__builtin_bit_cast(float, bw.x << 16), __builtin_bit_cast(float, bw.x & 0xffff0000u), __builtin_bit_cast(float, bw.y << 16), __builtin_bit_cast(float, bw.y & 0xffff0000u)};
                        *(f32x4*)(out + off + bj * HALF + n * 16) = b + acc[ai][bj][m][n]; }
                asm volatile("" ::: "memory"); }
    }
};
struct EpiSwiglu {
    static constexpr bool PERM = true, AFTER_DRAIN = false;
    bf16_t* O; int ldh; const float* ssq;
    __device__ __forceinline__ void operator()(const f32x4 (&acc)[2][2][4][2], const Unit& u, int wr, int wc, int fr, int fq) const {
        typedef unsigned u32x2v __attribute__((ext_vector_type(2)));
        const int row0 = u.pm * BM + wr * 64 + fr; const int h0 = u.pn * 128 + wc * 16 + 4 * fq;
#pragma unroll
        for (int ai = 0; ai < 2; ++ai)
#pragma unroll
            for (int m = 0; m < 4; ++m) { const int row = row0 + ai * HALF + m * 16; bf16_t* rowp = O + (size_t)row * ldh + h0;
                const float rs = 1.0f / sqrtf(ssq[row] * (1.0f / 2048.0f) + 1e-6f);
#pragma unroll
                for (int bj = 0; bj < 2; ++bj) { const f32x4 g = acc[ai][bj][m][0] * rs, up = acc[ai][bj][m][1] * rs; float v[4];
#pragma unroll
                    for (int e = 0; e < 4; ++e) v[e] = g[e] * __builtin_amdgcn_rcpf(1.0f + __expf(-g[e])) * up[e];
                    u32x2v w; w.x = cvt_pk_bf16(v[0], v[1]); w.y = cvt_pk_bf16(v[2], v[3]);
                    *(u32x2v*)(rowp + bj * 64) = w; } }
    }
};
template <class Epi, class Sched, bool ALIGN_EPI = false, bool SP2 = false>
__device__ __forceinline__ void gemm_phase(PG8_LAS unsigned char* lds, const Gemm g, const Sched& S, const Epi& E) {
    const int tid = threadIdx.x, wid = __builtin_amdgcn_readfirstlane(tid >> 6), lane = tid & 63, wr = wid >> 2, wc = wid & 3, fr = lane & 15, fq = lane >> 4;
    const int K = g.K, nt = K / BK;
    unsigned voffA[2], voffB[2];
#pragma unroll
    for (int i = 0; i < 2; ++i) { int R, C; stage_rc(tid * 16 + i * 8192, R, C); const int Rb = Epi::PERM ? ((R & ~31) + perm32(R & 31)) : R;
        voffA[i] = (unsigned)(R * K + C) * 2u; voffB[i] = (unsigned)(Rb * K + C) * 2u; }
    const size_t kstep = (size_t)(BK * 2);
    const size_t hstep = (size_t)HALF * K * 2;
    const size_t tstep = 2 * hstep;
    const unsigned ldsw = (unsigned)wid * 1024u;
    const int aoff = lds_byte(wr * 64 + fr, fq * 8), boff = lds_byte(wc * 32 + fr, fq * 8);
#define PG8_SA(b, h) (((b) * 2 + (h)) * HTB)
#define PG8_SB(b, h) ((4 + (b) * 2 + (h)) * HTB)
#define PG8_STAGE(bufoff, gbase, voff) do { _Pragma("unroll") for (int _i = 0; _i < 2; ++_i) \
        __builtin_amdgcn_global_load_lds((const unsigned*)((const char*)(gbase) + (voff)[_i]), (PG8_LAS unsigned*)(lds + (bufoff) + ldsw + _i * 8192), 16, 0, 0); } while (0)
#define PG8_LDA(dst, b, h) do { _Pragma("unroll") for (int m = 0; m < 4; ++m) _Pragma("unroll") for (int k = 0; k < 2; ++k) dst[m][k] = *(const PG8_LAS bf16x8*)(lds + PG8_SA(b, h) + aoff + m * 2048 + k * 1024); } while (0)
#define PG8_LDB(dst, b, h) do { _Pragma("unroll") for (int n = 0; n < 2; ++n) _Pragma("unroll") for (int k = 0; k < 2; ++k) dst[n][k] = *(const PG8_LAS bf16x8*)(lds + PG8_SB(b, h) + boff + n * 2048 + k * 1024); } while (0)
#define PG8_MMA(ai, bj, At, Bt) do { __builtin_amdgcn_s_setprio(1); _Pragma("unroll") for (int m = 0; m < 4; ++m) _Pragma("unroll") for (int n = 0; n < 2; ++n) _Pragma("unroll") for (int k = 0; k < 2; ++k) \
        acc[ai][bj][m][n] = __builtin_amdgcn_mfma_f32_16x16x32_bf16(Bt[n][k], At[m][k], acc[ai][bj][m][n], 0, 0, 0); __builtin_amdgcn_s_setprio(0); } while (0)
#define PG8_WAIT_V(n) asm volatile("s_waitcnt vmcnt(" #n ")" ::: "memory")
#define PG8_WAIT_L(n) asm volatile("s_waitcnt lgkmcnt(" #n ")" ::: "memory")
#define PG8_BAR __builtin_amdgcn_s_barrier()
#define PG8_SCHED __builtin_amdgcn_sched_barrier(0)
    Unit cur, nxt; int ui = 0;
    if (!S.next(0, cur)) return;
    f32x4 acc[2][2][4][2];
#pragma unroll
    for (int a = 0; a < 2; ++a)
#pragma unroll
        for (int b = 0; b < 2; ++b)
#pragma unroll
            for (int m = 0; m < 4; ++m)
#pragma unroll
                for (int n = 0; n < 2; ++n) acc[a][b][m][n] = (f32x4){0.f, 0.f, 0.f, 0.f};
    bf16x8 At[4][2], B0[2][2], B1[2][2];
    const char* cA = (const char*)g.A + (size_t)cur.pm * tstep; const char* cB = (const char*)g.Bt + (size_t)cur.pn * tstep;
    S.a_ready(cur);
    if constexpr (SP2) {
        PG8_STAGE(PG8_SB(0, 0), cB, voffB); PG8_STAGE(PG8_SB(0, 1), cB + hstep, voffB); PG8_STAGE(PG8_SA(0, 0), cA, voffA); PG8_STAGE(PG8_SA(0, 1), cA + hstep, voffA);
        if (wr == 1) PG8_BAR;
        PG8_WAIT_V(2); PG8_BAR;
        PG8_STAGE(PG8_SB(1, 0), cB + kstep, voffB); PG8_STAGE(PG8_SA(1, 0), cA + kstep, voffA); PG8_STAGE(PG8_SB(1, 1), cB + hstep + kstep, voffB);
        PG8_WAIT_V(6); PG8_BAR;
    } else {
        PG8_STAGE(PG8_SB(0, 0), cB, voffB); PG8_STAGE(PG8_SA(0, 0), cA, voffA); PG8_STAGE(PG8_SB(0, 1), cB + hstep, voffB); PG8_STAGE(PG8_SA(0, 1), cA + hstep, voffA);
        if (wr == 1) PG8_BAR;
        PG8_WAIT_V(4); PG8_BAR;
        PG8_STAGE(PG8_SB(1, 0), cB + kstep, voffB); PG8_STAGE(PG8_SA(1, 0), cA + kstep, voffA); PG8_STAGE(PG8_SB(1, 1), cB + hstep + kstep, voffB);
        PG8_WAIT_V(6); PG8_BAR;
    }
    for (;;) {
        const bool has_next = S.next(ui + 1, nxt);
        const char* nA = has_next ? (const char*)g.A + (size_t)nxt.pm * tstep : cA; const char* nB = has_next ? (const char*)g.Bt + (size_t)nxt.pn * tstep : cB;
        for (int t = 0; t < nt; t += 2) {
            const bool last = (t == nt - 2);
            const char* a1 = cA + (size_t)(t + 1) * kstep;
            const char* a2 = last ? nA : cA + (size_t)(t + 2) * kstep; const char* b2 = last ? nB : cB + (size_t)(t + 2) * kstep;
            const char* a3 = a2 + kstep; const char* b3 = b2 + kstep;
            if (last && has_next) S.a_ready(nxt);
            if constexpr (SP2) {
            PG8_LDB(B0, 0, 0); PG8_LDB(B1, 0, 1); PG8_SCHED; PG8_LDA(At, 0, 0); PG8_STAGE(PG8_SA(1, 1), a1 + hstep, voffA);
            PG8_WAIT_V(8); PG8_WAIT_L(0); PG8_BAR; PG8_MMA(0, 0, At, B0); PG8_MMA(0, 1, At, B1); PG8_BAR; PG8_SCHED;
            PG8_LDA(At, 0, 1); PG8_STAGE(PG8_SB(0, 0), b2, voffB); PG8_STAGE(PG8_SB(0, 1), b2 + hstep, voffB); PG8_STAGE(PG8_SA(0, 0), a2, voffA);
            PG8_WAIT_V(8); PG8_WAIT_L(0); PG8_BAR; PG8_MMA(1, 0, At, B0); PG8_MMA(1, 1, At, B1); PG8_BAR; PG8_SCHED;
            PG8_LDB(B0, 1, 0); PG8_LDB(B1, 1, 1); PG8_SCHED; PG8_LDA(At, 1, 0); PG8_STAGE(PG8_SA(0, 1), a2 + hstep, voffA);
            PG8_WAIT_V(8); PG8_WAIT_L(0); PG8_BAR; PG8_MMA(0, 0, At, B0); PG8_MMA(0, 1, At, B1); PG8_BAR; PG8_SCHED;
            PG8_LDA(At, 1, 1); PG8_STAGE(PG8_SB(1, 0), b3, voffB); PG8_STAGE(PG8_SB(1, 1), b3 + hstep, voffB); PG8_STAGE(PG8_SA(1, 0), a3, voffA);
            PG8_WAIT_V(8); PG8_WAIT_L(0); PG8_BAR; PG8_MMA(1, 0, At, B0); PG8_MMA(1, 1, At, B1); PG8_BAR; PG8_SCHED;
            } else {
            PG8_LDB(B0, 0, 0); PG8_SCHED; PG8_LDA(At, 0, 0); PG8_STAGE(PG8_SA(1, 1), a1 + hstep, voffA);
            PG8_WAIT_L(8); PG8_BAR; PG8_WAIT_L(0); PG8_MMA(0, 0, At, B0); PG8_BAR; PG8_SCHED;
            PG8_LDB(B1, 0, 1); PG8_STAGE(PG8_SB(0, 0), b2, voffB);
            PG8_BAR; PG8_WAIT_L(0); PG8_MMA(0, 1, At, B1); PG8_BAR;
            PG8_LDA(At, 0, 1); PG8_STAGE(PG8_SA(0, 0), a2, voffA);
            PG8_BAR; PG8_WAIT_L(0); PG8_MMA(1, 0, At, B0); PG8_BAR; PG8_SCHED;
            PG8_STAGE(PG8_SB(0, 1), b2 + hstep, voffB);
            PG8_WAIT_V(6); PG8_BAR; PG8_MMA(1, 1, At, B1); PG8_BAR;
            PG8_LDB(B0, 1, 0); PG8_SCHED; PG8_LDA(At, 1, 0); PG8_STAGE(PG8_SA(0, 1), a2 + hstep, voffA);
            PG8_WAIT_L(8); PG8_BAR; PG8_WAIT_L(0); PG8_MMA(0, 0, At, B0); PG8_BAR; PG8_SCHED;
            PG8_LDB(B1, 1, 1); PG8_STAGE(PG8_SB(1, 0), b3, voffB);
            PG8_BAR; PG8_WAIT_L(0); PG8_MMA(0, 1, At, B1); PG8_BAR;
            PG8_LDA(At, 1, 1); PG8_STAGE(PG8_SA(1, 0), a3, voffA);
            PG8_BAR; PG8_WAIT_L(0); PG8_MMA(1, 0, At, B0); PG8_BAR; PG8_SCHED;
            PG8_STAGE(PG8_SB(1, 1), b3 + hstep, voffB);
            PG8_WAIT_V(6); PG8_BAR; PG8_MMA(1, 1, At, B1); PG8_BAR;
            }
        }
        if constexpr (ALIGN_EPI) { if (wr == 0) PG8_BAR; }
        if constexpr (!Epi::AFTER_DRAIN) { E(acc, cur, wr, wc, fr, fq); S.done(cur); }
        if (!has_next) break;
#pragma unroll
        for (int a = 0; a < 2; ++a)
#pragma unroll
            for (int b = 0; b < 2; ++b)
#pragma unroll
                for (int m = 0; m < 4; ++m)
#pragma unroll
                    for (int n = 0; n < 2; ++n) acc[a][b][m][n] = (f32x4){0.f, 0.f, 0.f, 0.f};
        cur = nxt; cA = nA; cB = nB; ++ui;
        if constexpr (ALIGN_EPI) { if (wr == 1) PG8_BAR; }
    }
    PG8_WAIT_V(0);
    if constexpr (!ALIGN_EPI) { if (wr == 0) PG8_BAR; }
    PG8_BAR;
    if constexpr (Epi::AFTER_DRAIN) { E.fused(acc, cur, wr, wc, fr, fq, lds, wid, lane); S.done(cur); }
#undef PG8_SA
#undef PG8_SB
#undef PG8_STAGE
#undef PG8_LDA
#undef PG8_LDB
#undef PG8_MMA
#undef PG8_WAIT_V
#undef PG8_WAIT_L
#undef PG8_BAR
#undef PG8_SCHED
}
}

#define LAS __attribute__((address_space(3)))
typedef unsigned short bf16;
typedef unsigned v4u __attribute__((ext_vector_type(4)));
typedef unsigned v2u __attribute__((ext_vector_type(2)));
typedef float f32x4 __attribute__((ext_vector_type(4)));
constexpr int NWAVES = 8, NTHR = 512;
constexpr int DM = 2048, NB = 4, SEQ = 2048, T = NB * SEQ, DEPTH = 2;
constexpr int NIN = 6160, NPROJ = 6144, FFN = 5632, NGU = 2 * FFN;
constexpr int LDP = 3072;
constexpr int C_QA = 0, C_KA = 512, C_VA = 1024, C_RA = 2048, C_QB = 3072, C_KB = 4096, C_VB = 5120;
constexpr float RMS_EPS = 1e-6f;
constexpr size_t MiB = 1u << 20;
constexpr size_t WS_MB = 49152;
constexpr size_t WS_CTL = 0, CTL_ZERO_BYTES = 65536;
constexpr size_t WS_WIN = 1 * MiB, WS_WOUT = 49 * MiB, WS_WGU = 65 * MiB, WS_WD = 153 * MiB, WS_XB = 197 * MiB, WS_PROJ = 229 * MiB, WS_HMID = 229 * MiB,
                 WS_GA = 325 * MiB, WS_MIX = 326 * MiB, WS_QT = 358 * MiB, WS_KD = 366 * MiB, WS_VT = 374 * MiB, WS_PT = 390 * MiB, WS_DEC = 394 * MiB, WS_SN = 395 * MiB, WS_WGA = 427 * MiB, WS_SSQ = 428 * MiB, WS_OP2 = 429 * MiB, WS_LP = 445 * MiB, WS_END = 446 * MiB;
constexpr size_t SZ_WIN = (size_t)NPROJ * DM * 2, SZ_WOUT = (size_t)DM * DM * 2, SZ_WGU = (size_t)NGU * DM * 2, SZ_WD = (size_t)DM * FFN * 2;
static_assert(WS_WIN + 2 * SZ_WIN <= WS_WOUT && WS_WOUT + 2 * SZ_WOUT <= WS_WGU && WS_WGU + 2 * SZ_WGU <= WS_WD && WS_WD + 2 * SZ_WD <= WS_XB, "ws map (weights)");
static_assert(WS_XB + (size_t)T * DM * 2 <= WS_PROJ && WS_PROJ + (size_t)T * NPROJ * 2 <= WS_GA && WS_HMID + (size_t)T * FFN * 2 <= WS_GA && WS_GA + (size_t)T * 16 * 4 <= WS_MIX && WS_MIX + (size_t)T * DM * 2 <= WS_QT, "ws map (activations)");
constexpr int LDS_BYTES = 147456;

__device__ const unsigned char kBucket[3][129] = {
 {0,1,2,3,4,5,6,7,8,9,10,11,12,13,14,15,16,16,16,16,16,16,17,17,17,17,17,17,17,17,18,18,18,18,18,18,18,18,18,18,19,19,19,19,19,19,19,19,19,19,19,19,19,19,20,20,20,20,20,20,20,20,20,20,20,20,20,20,20,20,20,20,20,21,21,21,21,21,21,21,21,21,21,21,21,21,21,21,21,21,21,21,21,21,21,21,21,21,21,22,22,22,22,22,22,22,22,22,22,22,22,22,22,22,22,22,22,22,22,22,22,22,22,22,22,22,22,22,22},
 {0,4,8,12,16,16,17,17,18,18,19,19,19,19,20,20,20,20,20,21,21,21,21,21,21,22,22,22,22,22,22,22,22,22,23,23,23,23,23,23,23,23,23,23,23,23,24,24,24,24,24,24,24,24,24,24,24,24,24,24,24,24,25,25,25,25,25,25,25,25,25,25,25,25,25,25,25,25,25,25,25,25,25,26,26,26,26,26,26,26,26,26,26,26,26,26,26,26,26,26,26,26,26,26,26,26,26,26,26,26,26,26,26,27,27,27,27,27,27,27,27,27,27,27,27,27,27,27,27},
 {0,16,18,19,20,21,21,22,22,23,23,23,24,24,24,24,25,25,25,25,25,26,26,26,26,26,26,26,26,27,27,27,27,27,27,27,27,27,27,28,28,28,28,28,28,28,28,28,28,28,28,28,29,29,29,29,29,29,29,29,29,29,29,29,29,29,29,29,29,29,30,30,30,30,30,30,30,30,30,30,30,30,30,30,30,30,30,30,30,30,30,30,30,30,30,31,31,31,31,31,31,31,31,31,31,31,31,31,31,31,31,31,31,31,31,31,31,31,31,31,31,31,31,31,31,31,31,31,31}};

#define LDS_WAIT() asm volatile("s_waitcnt lgkmcnt(0)" ::: "memory")
#define LDS_BARRIER() do { asm volatile("s_waitcnt lgkmcnt(0)" ::: "memory"); __builtin_amdgcn_s_barrier(); asm volatile("" ::: "memory"); } while (0)
typedef float f32x2_t __attribute__((ext_vector_type(2))); typedef __bf16 bf16x2_t __attribute__((ext_vector_type(2)));
__device__ __forceinline__ unsigned pk2(float lo, float hi) { const f32x2_t v = {lo, hi}; return __builtin_bit_cast(unsigned, __builtin_convertvector(v, bf16x2_t)); }
__device__ __forceinline__ unsigned f2bf(float f) { return pk2(f, 0.f) & 0xffffu; }
__device__ __forceinline__ float bf2f(unsigned h) { return __builtin_bit_cast(float, h << 16); }
__device__ __forceinline__ float bflo(unsigned w) { return __builtin_bit_cast(float, w << 16); }
__device__ __forceinline__ float bfhi(unsigned w) { return __builtin_bit_cast(float, w & 0xffff0000u); }
__device__ __forceinline__ float wave_sum(float v) {
#pragma unroll
    for (int o = 1; o < 64; o <<= 1) v += __shfl_xor(v, o);
    return v;
}

#define XB_TMO      128
#define XB_XCNT(j)  (256  + 64 * (j))
#define XB_XSUB(j)  (1280 + 64 * (j))
#define XB_XGEN(j)  (2304 + 64 * (j))
#define XB_TOP      3328
#define XB_TOPGEN   3392
#define XCD_BAR_WORDS 3456
#define XB_SPIN_CAP (1u << 18)

__device__ __forceinline__ unsigned xb_ld(unsigned* p)              { return __hip_atomic_load(p, __ATOMIC_RELAXED, __HIP_MEMORY_SCOPE_AGENT); }
__device__ __forceinline__ unsigned xb_add(unsigned* p, unsigned v) { return __hip_atomic_fetch_add(p, v, __ATOMIC_RELAXED, __HIP_MEMORY_SCOPE_AGENT); }
__device__ __forceinline__ unsigned xb_xcc_id() { return (unsigned)__builtin_amdgcn_s_getreg((3 << 11) | 20) & 0xFu; }
#define XB_SPIN(cond, bar) do { unsigned _sp = 0; while (cond) { __builtin_amdgcn_s_sleep(1); \
    if ((++_sp & 255u) == 0u) { if (xb_ld(&(bar)[XB_TMO])) break; if (_sp > XB_SPIN_CAP) { atomicAdd(&(bar)[XB_TMO], 1u); break; } } } } while (0)

#ifndef CODE_AHEAD
#define CODE_AHEAD 32768
#endif
struct XcdBarrier {
    unsigned* bar; unsigned x;
    volatile LAS unsigned* st;
};

__device__ __forceinline__ XcdBarrier xcd_barrier_post(unsigned* bar, volatile LAS unsigned* st) {
    XcdBarrier b; b.bar = bar; b.x = xb_xcc_id(); b.st = st;
    if (threadIdx.x == 0) (void)xb_add(&bar[XB_XCNT(b.x)], 1u);
    return b;
}
__device__ __forceinline__ void xcd_barrier_complete(unsigned* bar, unsigned x, unsigned& nloc, unsigned& nx) {
    const unsigned G = gridDim.x * gridDim.y * gridDim.z;
    unsigned sum, cnt, mine, sp = 0u;
    for (;;) {
        sum = 0u; cnt = 0u; mine = 0u;
#pragma unroll
        for (unsigned j = 0; j < 16; ++j) { const unsigned c = xb_ld(&bar[XB_XCNT(j)]); sum += c; cnt += (c > 0u) ? 1u : 0u; mine = (j == x) ? c : mine; }
        if (sum == G) break;
        __builtin_amdgcn_s_sleep(1);
        if ((++sp & 255u) == 0u) { if (xb_ld(&bar[XB_TMO])) break; if (sp > XB_SPIN_CAP) { atomicAdd(&bar[XB_TMO], 1u); break; } }
    }
    nloc = mine > 0u ? mine : 1u; nx = cnt > 0u ? cnt : 1u;
}

__device__ __forceinline__ void xcd_arrive(const XcdBarrier& b, const bool warm = true) {
    asm volatile("s_waitcnt vmcnt(0)" ::: "memory");
    __syncthreads();
    if (threadIdx.x == 0) {
        unsigned* bar = b.bar;
        __builtin_amdgcn_s_waitcnt(0);
        unsigned nloc = b.st[0], nx = b.st[1];
        if (nloc == 0u) { xcd_barrier_complete(bar, b.x, nloc, nx); b.st[0] = nloc; b.st[1] = nx; }
        const unsigned old = xb_add(&bar[XB_XSUB(b.x)], 1u);
        const unsigned gen = old / nloc;
        b.st[2] = (gen + 1u) * nx;
        asm volatile("buffer_inv sc1" ::: "memory");
        if (old + 1u == (gen + 1u) * nloc) {
            __builtin_amdgcn_fence(__ATOMIC_RELEASE, "agent");
            asm volatile("s_waitcnt vmcnt(0)" ::: "memory");
            (void)xb_add(&bar[XB_TOP], 1u);
        }
    }
    if (warm) { unsigned long long pc; asm volatile("s_getpc_b64 %0" : "=s"(pc));
        if (threadIdx.x < CODE_AHEAD / 128) { const unsigned* p = (const unsigned*)(pc + (unsigned long long)threadIdx.x * 128u); unsigned v;
            asm volatile("global_load_dword %0, %1, off\n\ts_waitcnt vmcnt(0)" : "=v"(v) : "v"(p) : "memory"); } }
}
__device__ __forceinline__ void xcd_wait(const XcdBarrier& b) {
    __syncthreads();
    if (threadIdx.x == 0) {
        unsigned* bar = b.bar;
        const unsigned target = b.st[2];
        XB_SPIN((int)(xb_ld(&bar[XB_TOP]) - target) < 0, bar);
        asm volatile("s_waitcnt vmcnt(0)" ::: "memory");
    }
    __syncthreads();
}
__device__ __forceinline__ void xcd_barrier(const XcdBarrier& b, const bool warm = true) { xcd_arrive(b, warm); xcd_wait(b); }


struct Ctx {
    LAS unsigned char* lds; int tid, lane, wave, G, bid;
    const float *x, *norm1_g, *w_in, *gate_w2, *gate_b, *onorm_g, *qn_g, *kn_g, *rel_bias, *w_out, *norm2_g, *w_gate, *w_up, *w_down;
    float* out; unsigned char* ws;
    XcdBarrier bar;
};

struct ConvItem { const float* src; bf16* dst; const float* gk; int ldw, K, mode, n0; };
__device__ __forceinline__ ConvItem conv_item_of(const Ctx& F, int it) {
    constexpr int I_IN = (DM / 128) * (NPROJ / 256), I_OUT = (DM / 128) * (DM / 256), I_G = (DM / 128) * (FFN / 256), I_D = (FFN / 128) * (DM / 256);
    constexpr int PER_LAYER = I_IN + I_OUT + 2 * I_G + I_D;
    const int l = it / PER_LAYER; int r = it % PER_LAYER; ConvItem c; c.gk = nullptr; c.mode = 0;
    if (r < I_IN) { const int nblk = NPROJ / 256, kb = r / nblk, n0 = 256 * (r % nblk); const int src0 = n0 + (n0 >= 3072 ? 16 : 0);
        c.src = F.w_in + ((size_t)l * DM + 128 * kb) * NIN + src0; c.ldw = NIN; c.dst = (bf16*)(F.ws + WS_WIN + l * SZ_WIN) + 128 * kb; c.K = DM; c.n0 = n0; c.gk = F.norm1_g + l * DM + 128 * kb; return c; }
    r -= I_IN;
    if (r < I_OUT) { const int nblk = DM / 256, kb = r / nblk, n0 = 256 * (r % nblk);
        c.src = F.w_out + ((size_t)l * DM + 128 * kb) * DM + n0; c.ldw = DM; c.dst = (bf16*)(F.ws + WS_WOUT + l * SZ_WOUT) + 128 * kb; c.K = DM; c.n0 = n0; return c; }
    r -= I_OUT;
    if (r < 2 * I_G) { const int up = r >= I_G; if (up) r -= I_G; const int nblk = FFN / 256, kb = r / nblk, n0 = 256 * (r % nblk);
        c.src = (up ? F.w_up : F.w_gate) + ((size_t)l * DM + 128 * kb) * FFN + n0; c.ldw = FFN; c.dst = (bf16*)(F.ws + WS_WGU + l * SZ_WGU) + 128 * kb; c.K = DM; c.n0 = n0; c.mode = 1 + up; c.gk = F.norm2_g + l * DM + 128 * kb; return c; }
    r -= 2 * I_G;
    { const int nblk = DM / 256, kb = r / nblk, n0 = 256 * (r % nblk);
        c.src = F.w_down + ((size_t)l * FFN + 128 * kb) * DM + n0; c.ldw = DM; c.dst = (bf16*)(F.ws + WS_WD + l * SZ_WD) + 128 * kb; c.K = FFN; c.n0 = n0; return c; }
}
__device__ __forceinline__ void conv_load(const ConvItem& c, f32x4 (&v)[16], int tid) {
    const int r8 = tid >> 6, c4 = tid & 63;
#pragma unroll
    for (int i = 0; i < 16; ++i) v[i] = *(const f32x4*)(c.src + (size_t)(8 * i + r8) * c.ldw + 4 * c4);
}
__device__ __forceinline__ void conv_store(const ConvItem& c, const f32x4 (&v)[16], LAS float* scr, int tid) {
    const int r8 = tid >> 6, c4 = tid & 63;
#pragma unroll
    for (int i = 0; i < 16; ++i) { LAS float* p = scr + (8 * i + r8) * 257 + 4 * c4; const float gs = c.gk ? c.gk[8 * i + r8] : 1.0f; p[0] = v[i].x * gs; p[1] = v[i].y * gs; p[2] = v[i].z * gs; p[3] = v[i].w * gs; }
    __syncthreads();
    const int cc = tid & 15, nr = tid >> 4;
#pragma unroll
    for (int j = 0; j < 8; ++j) { const int n = nr + 32 * j; const LAS float* sp = scr + (8 * cc) * 257 + n;
        v4u o; o.x = pk2(sp[0 * 257], sp[1 * 257]); o.y = pk2(sp[2 * 257], sp[3 * 257]); o.z = pk2(sp[4 * 257], sp[5 * 257]); o.w = pk2(sp[6 * 257], sp[7 * 257]);
        const int h = c.n0 + n; const int row = c.mode == 0 ? h : ((h >> 2) * 8 + (h & 3) + 4 * (c.mode - 1));
        *(v4u*)(c.dst + (size_t)row * c.K + 8 * cc) = o; }
    __syncthreads();
}
__device__ __forceinline__ void phase_convert(const Ctx& F) {
    LAS float* scr = (LAS float*)F.lds;
    constexpr int NITEMS = DEPTH * ((DM / 128) * (NPROJ / 256) + (DM / 128) * (DM / 256) + 2 * (DM / 128) * (FFN / 256) + (FFN / 128) * (DM / 256));
    {   f32x4 va[16], vb[16]; int it = F.bid;
        ConvItem ca = conv_item_of(F, it < NITEMS ? it : 0), cb = ca;
        if (it < NITEMS) conv_load(ca, va, F.tid);
#pragma unroll 1
        while (it < NITEMS) {
            const int itb = it + F.G; if (itb < NITEMS) { cb = conv_item_of(F, itb); conv_load(cb, vb, F.tid); }
            conv_store(ca, va, scr, F.tid);
            if (itb >= NITEMS) break;
            const int ita = itb + F.G; if (ita < NITEMS) { ca = conv_item_of(F, ita); conv_load(ca, va, F.tid); }
            conv_store(cb, vb, scr, F.tid);
            it = ita;
        }
    }
    const int gt = F.bid * NTHR + F.tid, NGT = F.G * NTHR;
    for (int i = gt; i < DEPTH * 16 * DM; i += NGT) { const int l = i / (16 * DM), j = (i / DM) & 15, k = i % DM;
        ((bf16*)(F.ws + WS_WGA))[i] = (bf16)f2bf(F.norm1_g[l * DM + k] * F.w_in[((size_t)l * DM + k) * NIN + 3072 + j]); }
    for (int i = gt; i < 4 * T; i += NGT) ((float*)(F.ws + WS_SSQ))[T + i] = 0.f;
    if (F.bid == F.G - 1) {
        LAS float* red = (LAS float*)F.lds;
        __syncthreads();
        if (F.wave < DEPTH) { const float* qg = F.qn_g + F.wave * 128; const float* kg = F.kn_g + F.wave * 128;
            float v = fmaxf(fabsf(qg[F.lane] * kg[F.lane]), fabsf(qg[F.lane + 64] * kg[F.lane + 64]));
#pragma unroll
            for (int o = 1; o < 64; o <<= 1) v = fmaxf(v, __shfl_xor(v, o));
            if (F.lane == 0) red[F.wave] = v; }
        if (F.wave == DEPTH) { const int h = F.lane & 7, kg4 = F.lane >> 3; float v = -INFINITY;
#pragma unroll
            for (int k = 0; k < 4; ++k) v = fmaxf(v, F.rel_bias[(4 * kg4 + k) * 8 + h]);
            v = fmaxf(v, __shfl_xor(v, 8)); v = fmaxf(v, __shfl_xor(v, 16)); v = fmaxf(v, __shfl_xor(v, 32));
            if (F.lane < 8) red[DEPTH + F.lane] = v; }
        __syncthreads();
        if (F.tid < DEPTH * 8) ((float*)(F.ws + WS_MB))[F.tid] = red[F.tid >> 3] * 11.313708498984761f * 1.02f + red[DEPTH + (F.tid & 7)];
    }
}

__device__ __forceinline__ void phase_norm(const Ctx& F, const float* x, bf16* xb, float* ssq) {
    const int gw = F.bid * NWAVES + F.wave, NGW = F.G * NWAVES, lane = F.lane;
    for (int m = gw; m < T; m += NGW) {
        const f32x4* xr = (const f32x4*)(x + (size_t)m * DM) + lane;
        f32x4 v[8]; float s = 0.f;
#pragma unroll
        for (int j = 0; j < 8; ++j) { v[j] = xr[64 * j]; s += (v[j].x * v[j].x + v[j].y * v[j].y) + (v[j].z * v[j].z + v[j].w * v[j].w); }
        s = wave_sum(s);
        v2u* o8 = (v2u*)(xb + (size_t)m * DM) + lane;
#pragma unroll
        for (int j = 0; j < 8; ++j) { v2u w; w.x = pk2(v[j].x, v[j].y); w.y = pk2(v[j].z, v[j].w); o8[64 * j] = w; }
        if (lane == 0) ssq[m] = s;
    }
}

typedef short bf16x8 __attribute__((ext_vector_type(8)));
constexpr int NCHUNK = NB * 4 * 32;
__device__ __forceinline__ void gla_prep_item(const Ctx& F, int item, const bf16* proj, const bf16* xb, const float* ssq, const bf16* wga, const float* w2, const float* gb, bf16* QT, bf16* KD, bf16* VT, bf16* PT, float* DEC) {
    const int b = item >> 6, n = (item >> 1) & 31, hp = item & 1, tid = F.tid, col = tid & 127, rg = tid >> 7, lane = F.lane, fr = lane & 15, fg = lane >> 4;
    const size_t m0 = (size_t)b * SEQ + n * 64;
    LAS float* GAl = (LAS float*)F.lds;
    LAS float* TOT = GAl + 1024;
    LAS bf16* Ql = (LAS bf16*)(F.lds + 6144);
    LAS bf16* Kl = (LAS bf16*)(F.lds + 23552);
    LAS bf16* Vl = (LAS bf16*)(F.lds + 40960);
    LAS float* GP = (LAS float*)(F.lds + 74752);
    v4u ql[2], kl[2], vl[4];
#define PREP_LOAD(h_) do { \
        _Pragma("unroll") for (int e = 0; e < 2; ++e) { const int idx = tid + 512 * e, row = idx >> 4, pc = idx & 15; \
            ql[e] = *(const v4u*)(proj + (m0 + row) * LDP + C_QA + (h_) * 128 + pc * 8); kl[e] = *(const v4u*)(proj + (m0 + row) * LDP + C_KA + (h_) * 128 + pc * 8); } \
        _Pragma("unroll") for (int e = 0; e < 4; ++e) { const int idx = tid + 512 * e, row = idx >> 5, pc = idx & 31; vl[e] = *(const v4u*)(proj + (m0 + row) * LDP + C_VA + (h_) * 256 + pc * 8); } } while (0)
    xcd_arrive(F.bar);
    float w2c[16]; float bias = gb[(2 * hp) * 128 + col];
#pragma unroll
    for (int j = 0; j < 16; ++j) w2c[j] = w2[j * 512 + (2 * hp) * 128 + col];
    {
        constexpr int XS = 520;
        LAS bf16* XB0 = (LAS bf16*)(F.lds + 8192); LAS bf16* XB1 = XB0 + 64 * XS;
        f32x4 gacc[4];
#pragma unroll
        for (int rt = 0; rt < 4; ++rt) gacc[rt] = (f32x4){0.f, 0.f, 0.f, 0.f};
        v4u xr[8], xq[8];
#define GA_LOAD(R_, sl_) do { _Pragma("unroll") for (int e = 0; e < 8; ++e) { const int idx = tid + 512 * e, row = idx >> 6, pc = idx & 63; R_[e] = *(const v4u*)(xb + (m0 + row) * DM + 512 * (sl_) + 8 * pc); } } while (0)
#define GA_STORE(R_, buf_) do { _Pragma("unroll") for (int e = 0; e < 8; ++e) { const int idx = tid + 512 * e, row = idx >> 6, pc = idx & 63; *(LAS v4u*)((buf_) + row * XS + 8 * pc) = R_[e]; } } while (0)
#define GA_COMP(buf_, sl_) do { _Pragma("unroll") for (int ks = 0; ks < 2; ++ks) { const int kl_ = 64 * F.wave + 32 * ks + 8 * fg; const bf16x8 B = *(const bf16x8*)(wga + fr * DM + 512 * (sl_) + kl_); \
            _Pragma("unroll") for (int rt = 0; rt < 4; ++rt) { const bf16x8 A = *(const LAS bf16x8*)((buf_) + (16 * rt + fr) * XS + kl_); gacc[rt] = __builtin_amdgcn_mfma_f32_16x16x32_bf16(A, B, gacc[rt], 0, 0, 0); } } } while (0)
        GA_LOAD(xr, 0); GA_LOAD(xq, 1); GA_STORE(xr, XB0); GA_LOAD(xr, 2); LDS_BARRIER();
        GA_COMP(XB0, 0); GA_STORE(xq, XB1); GA_LOAD(xq, 3); LDS_BARRIER();
        GA_COMP(XB1, 1); LDS_BARRIER();
        GA_STORE(xr, XB0); GA_STORE(xq, XB1);
        xcd_wait(F.bar);
        PREP_LOAD(2 * hp);
        GA_COMP(XB0, 2); GA_COMP(XB1, 3); LDS_BARRIER();
#undef GA_LOAD
#undef GA_STORE
#undef GA_COMP
#pragma unroll
        for (int rt = 0; rt < 4; ++rt)
#pragma unroll
            for (int e = 0; e < 4; ++e) GP[(F.wave * 64 + 16 * rt + 4 * fg + e) * 16 + fr] = gacc[rt][e];
        __syncthreads();
#pragma unroll
        for (int e = 0; e < 2; ++e) { const int idx = tid + 512 * e; float sum = 0.f;
#pragma unroll
            for (int w = 0; w < 8; ++w) sum += GP[w * 1024 + idx];
            GAl[idx] = sum * (1.0f / sqrtf(ssq[m0 + (idx >> 4)] * (1.0f / DM) + RMS_EPS)); }
    }
#pragma unroll 1
    for (int hh = 0; hh < 2; ++hh) {
    const int h = 2 * hp + hh, ch = (b * 4 + h) * 32 + n;
#pragma unroll
    for (int e = 0; e < 2; ++e) { const int idx = tid + 512 * e, row = idx >> 4, pc = idx & 15; *(LAS v4u*)(Ql + row * 136 + pc * 8) = ql[e]; *(LAS v4u*)(Kl + row * 136 + pc * 8) = kl[e]; }
#pragma unroll
    for (int e = 0; e < 4; ++e) { const int idx = tid + 512 * e, row = idx >> 5, pc = idx & 31; *(LAS v4u*)(Vl + row * 264 + pc * 8) = vl[e]; }
    if (hh == 0) PREP_LOAD(2 * hp + 1);
    __syncthreads();
    float pre[16]; float run = 0.f;
#pragma unroll
    for (int i = 0; i < 16; ++i) { const LAS f32x4* gr = (const LAS f32x4*)(GAl + (16 * rg + i) * 16); float gp = bias;
#pragma unroll
        for (int q = 0; q < 4; ++q) { const f32x4 gv = gr[q]; gp += gv.x * w2c[4 * q] + gv.y * w2c[4 * q + 1] + gv.z * w2c[4 * q + 2] + gv.w * w2c[4 * q + 3]; }
        run += (fminf(gp, 0.f) - __logf(1.0f + __expf(-fabsf(gp)))) * (1.0f / 16.0f); pre[i] = run; }
    TOT[rg * 128 + col] = run;
    if (hh == 0) { bias = gb[(2 * hp + 1) * 128 + col];
#pragma unroll
        for (int j = 0; j < 16; ++j) w2c[j] = w2[j * 512 + (2 * hp + 1) * 128 + col]; }
    LDS_BARRIER();
    float off = 0.f, blast = 0.f;
#pragma unroll
    for (int r4 = 0; r4 < 4; ++r4) { const float t = TOT[r4 * 128 + col]; if (r4 < rg) off += t; blast += t; }
    unsigned kdp[8];
#pragma unroll
    for (int i = 0; i < 16; i += 2) { float kd2[2];
#pragma unroll
        for (int u = 0; u < 2; ++u) { const int row = 16 * rg + i + u; const float bb = off + pre[i + u];
            const float qv = bf2f(Ql[row * 136 + col]), kv = bf2f(Kl[row * 136 + col]);
            Ql[row * 136 + col] = (bf16)f2bf(qv * 0.08838834764831845f * __expf(bb)); Kl[row * 136 + col] = (bf16)f2bf(kv * __expf(-bb)); kd2[u] = kv * __expf(blast - bb); }
        kdp[i >> 1] = pk2(kd2[0], kd2[1]); }
    { v4u* kdo = (v4u*)(KD + ((size_t)ch * 128 + col) * 64 + 16 * rg); kdo[0] = (v4u){kdp[0], kdp[1], kdp[2], kdp[3]}; kdo[1] = (v4u){kdp[4], kdp[5], kdp[6], kdp[7]}; }
    if (rg == 0) DEC[ch * 128 + col] = __expf(blast);
#pragma unroll
    for (int e = 0; e < 4; ++e) { const int idx = tid + 512 * e, dv = idx >> 3, oct = idx & 7; const LAS bf16* vp = Vl + (8 * oct) * 264 + dv;
        v4u o; o.x = (unsigned)vp[0] | ((unsigned)vp[264] << 16); o.y = (unsigned)vp[2 * 264] | ((unsigned)vp[3 * 264] << 16);
        o.z = (unsigned)vp[4 * 264] | ((unsigned)vp[5 * 264] << 16); o.w = (unsigned)vp[6 * 264] | ((unsigned)vp[7 * 264] << 16);
        *(v4u*)(VT + ((size_t)ch * 256 + dv) * 64 + 8 * oct) = o; }
    __syncthreads();
#pragma unroll
    for (int e = 0; e < 2; ++e) { const int idx = tid + 512 * e, row = idx >> 4, pc = idx & 15; *(v4u*)(QT + ((size_t)ch * 64 + row) * 128 + pc * 8) = *(const LAS v4u*)(Ql + row * 136 + pc * 8); }
    {   const int qt = F.wave >> 1;
#pragma unroll
        for (int jj = 0; jj < 2; ++jj) { const int jt = 2 * (F.wave & 1) + jj; f32x4 acc = {0.f, 0.f, 0.f, 0.f};
            if (jt <= qt) {
#pragma unroll
                for (int ks = 0; ks < 4; ++ks) { const bf16x8 A = *(const LAS bf16x8*)(Kl + (16 * jt + fr) * 136 + 32 * ks + 8 * fg), B = *(const LAS bf16x8*)(Ql + (16 * qt + fr) * 136 + 32 * ks + 8 * fg);
                    acc = __builtin_amdgcn_mfma_f32_16x16x32_bf16(A, B, acc, 0, 0, 0); } }
            const int iq = 16 * qt + fr, j0 = 16 * jt + 4 * fg;
            v2u w; w.x = pk2(j0 <= iq ? acc[0] : 0.f, j0 + 1 <= iq ? acc[1] : 0.f); w.y = pk2(j0 + 2 <= iq ? acc[2] : 0.f, j0 + 3 <= iq ? acc[3] : 0.f);
            *(v2u*)(PT + ((size_t)ch * 64 + iq) * 64 + j0) = w; } }
    __syncthreads();
    }
#undef PREP_LOAD
}
__device__ __forceinline__ void st16_wt(void* p, v4u v) { asm volatile("global_store_dwordx4 %0, %1, off sc1\n\ts_nop 2" :: "v"(p), "v"(v) : "memory"); }
constexpr int SC_ROW = 72, SC_KD_B = 128 * SC_ROW * 2, SC_VT_B = 128 * SC_ROW * 2, SC_SLOT = SC_KD_B + SC_VT_B + 512;
struct ScanRegs { v4u kd[2], vt[2], dc; };
__device__ __forceinline__ void gla_scan_block(const Ctx& F, int task, const bf16* KD, const bf16* VT, const float* DEC, bf16* SN) {
    const int bh = task >> 1, dvh = task & 1, tid = F.tid, lane = F.lane, fr = lane & 15, fg = lane >> 4, kh = F.wave >> 2, dq = F.wave & 3;
    f32x4 S[4][2];
#pragma unroll
    for (int kt = 0; kt < 4; ++kt)
#pragma unroll
        for (int dt = 0; dt < 2; ++dt) S[kt][dt] = (f32x4){0.f, 0.f, 0.f, 0.f};
#define SC_LOAD(R_, ch_) do { const int c_ = (ch_); \
        _Pragma("unroll") for (int e = 0; e < 2; ++e) R_.kd[e] = *(const v4u*)(KD + (size_t)c_ * 128 * 64 + (size_t)(tid + 512 * e) * 8); \
        _Pragma("unroll") for (int e = 0; e < 2; ++e) R_.vt[e] = *(const v4u*)(VT + ((size_t)c_ * 256 + 128 * dvh) * 64 + (size_t)(tid + 512 * e) * 8); \
        if (tid < 32) R_.dc = *(const v4u*)(DEC + (size_t)c_ * 128 + tid * 4); } while (0)
#define SC_STORE(R_, slot_) do { LAS unsigned char* sl_ = F.lds + (slot_) * SC_SLOT; \
        _Pragma("unroll") for (int e = 0; e < 2; ++e) { const int idx = tid + 512 * e; *(LAS v4u*)(sl_ + ((idx >> 3) * SC_ROW + (idx & 7) * 8) * 2) = R_.kd[e]; } \
        _Pragma("unroll") for (int e = 0; e < 2; ++e) { const int idx = tid + 512 * e; *(LAS v4u*)(sl_ + SC_KD_B + ((idx >> 3) * SC_ROW + (idx & 7) * 8) * 2) = R_.vt[e]; } \
        if (tid < 32) *(LAS v4u*)(sl_ + SC_KD_B + SC_VT_B + tid * 16) = R_.dc; } while (0)
#define SC_STEP(n_, RS_, RL_) do { const int ch = bh * 32 + (n_); \
          \
        _Pragma("unroll") for (int dt = 0; dt < 2; ++dt) _Pragma("unroll") for (int j = 0; j < 2; ++j) { v4u wv; wv.x = pk2(S[2 * j][dt][0], S[2 * j][dt][1]); wv.y = pk2(S[2 * j][dt][2], S[2 * j][dt][3]); \
            wv.z = pk2(S[2 * j + 1][dt][0], S[2 * j + 1][dt][1]); wv.w = pk2(S[2 * j + 1][dt][2], S[2 * j + 1][dt][3]); \
            st16_wt(SN + (((size_t)ch * 4 + 2 * kh + j) * 256 + 128 * dvh + 32 * dq + 16 * dt + fr) * 32 + 8 * fg, wv); } \
        if ((n_) < 31) { \
            const LAS unsigned char* sl = F.lds + ((n_) & 1) * SC_SLOT; \
            bf16x8 Bf[2][2]; \
            _Pragma("unroll") for (int dt = 0; dt < 2; ++dt) _Pragma("unroll") for (int ks = 0; ks < 2; ++ks) Bf[dt][ks] = *(const LAS bf16x8*)(sl + SC_KD_B + ((32 * dq + 16 * dt + fr) * SC_ROW + 32 * ks + 8 * fg) * 2); \
            _Pragma("unroll") for (int kt = 0; kt < 4; ++kt) {   \
                const f32x4 dd = *(const LAS f32x4*)(sl + SC_KD_B + SC_VT_B + (64 * kh + 32 * (kt >> 1) + 8 * fg + 4 * (kt & 1)) * 4); \
                const int kr = 64 * kh + 32 * (kt >> 1) + 8 * (fr >> 2) + 4 * (kt & 1) + (fr & 3); \
                const bf16x8 A0 = *(const LAS bf16x8*)(sl + (kr * SC_ROW + 8 * fg) * 2), A1 = *(const LAS bf16x8*)(sl + (kr * SC_ROW + 32 + 8 * fg) * 2); \
                _Pragma("unroll") for (int dt = 0; dt < 2; ++dt) { f32x4 sv = S[kt][dt] * dd; sv = __builtin_amdgcn_mfma_f32_16x16x32_bf16(A0, Bf[dt][0], sv, 0, 0, 0); \
                    S[kt][dt] = __builtin_amdgcn_mfma_f32_16x16x32_bf16(A1, Bf[dt][1], sv, 0, 0, 0); } } \
              \
            SC_STORE(RS_, ((n_) + 1) & 1); \
            SC_LOAD(RS_, bh * 32 + ((n_) + 3 < 31 ? (n_) + 3 : 30)); \
            LDS_BARRIER(); } } while (0)
    ScanRegs RA, RB;
    SC_LOAD(RA, bh * 32); SC_STORE(RA, 0);
    SC_LOAD(RA, bh * 32 + 1); SC_LOAD(RB, bh * 32 + 2);
    LDS_BARRIER();
#pragma unroll 1
    for (int n = 0; n < 32; n += 2) { SC_STEP(n, RA, RB); SC_STEP(n + 1, RB, RA); }
#undef SC_LOAD
#undef SC_STORE
#undef SC_STEP
    __syncthreads();
}
template <bool SPLIT> __device__ __forceinline__ void gla_out_chunk(const Ctx& F, int ch, const bf16* proj, const bf16* QT, const bf16* VT, const bf16* PT, const bf16* SN, const float* gon, bf16* mix) {
    const int bh = ch >> 5, n = ch & 31, b = bh >> 2, h = bh & 3, tid = F.tid, lane = F.lane, fr = lane & 15, fg = lane >> 4, qt = F.wave >> 1, dvh = F.wave & 1, iq = 16 * qt + fr;
    const size_t m = (size_t)b * SEQ + n * 64 + iq;
    LAS unsigned char* SNl = F.lds;
    LAS bf16* VTl = (LAS bf16*)(F.lds + 69632);
    LAS bf16* QTl = (LAS bf16*)(F.lds + 106496);
    LAS bf16* PTl = (LAS bf16*)(F.lds + 123904);
    LAS float* red = (LAS float*)(F.lds + 133120);
    v4u sn[8];
    {   v4u vt[4], q2[2], p1;
        if (!SPLIT) {
#pragma unroll
            for (int e = 0; e < 8; ++e) { const int idx = tid + 512 * e; sn[e] = *(const v4u*)(SN + (size_t)ch * 256 * 128 + (size_t)idx * 8); } }
#pragma unroll
        for (int e = 0; e < 4; ++e) { const int idx = tid + 512 * e; vt[e] = *(const v4u*)(VT + (size_t)ch * 256 * 64 + (size_t)idx * 8); }
#pragma unroll
        for (int e = 0; e < 2; ++e) { const int idx = tid + 512 * e; q2[e] = *(const v4u*)(QT + (size_t)ch * 64 * 128 + (size_t)idx * 8); }
        p1 = *(const v4u*)(PT + (size_t)ch * 64 * 64 + (size_t)tid * 8);
        if (!SPLIT) {
#pragma unroll
            for (int e = 0; e < 8; ++e) { const int idx = tid + 512 * e, kb = idx >> 10, dv = (idx >> 2) & 255; *(LAS v4u*)(SNl + kb * 17408 + dv * 64 + (dv >> 2) * 16 + (idx & 3) * 16) = sn[e]; } }
#pragma unroll
        for (int e = 0; e < 4; ++e) { const int idx = tid + 512 * e; *(LAS v4u*)(VTl + (idx >> 3) * 72 + (idx & 7) * 8) = vt[e]; }
#pragma unroll
        for (int e = 0; e < 2; ++e) { const int idx = tid + 512 * e; *(LAS v4u*)(QTl + (idx >> 4) * 136 + (idx & 15) * 8) = q2[e]; }
        *(LAS v4u*)(PTl + (tid >> 3) * 72 + (tid & 7) * 8) = p1;
    }
    v2u rw[8];
#pragma unroll
    for (int t = 0; t < 8; ++t) rw[t] = *(const v2u*)(proj + m * LDP + C_RA + h * 256 + 128 * dvh + 16 * t + 4 * fg);
    if (SPLIT) { xcd_wait(F.bar);
#pragma unroll
        for (int e = 0; e < 8; ++e) { const int idx = tid + 512 * e; sn[e] = *(const v4u*)(SN + (size_t)ch * 256 * 128 + (size_t)idx * 8); } }
    else __syncthreads();
    f32x4 acc[8];
#pragma unroll
    for (int t = 0; t < 8; ++t) acc[t] = (f32x4){0.f, 0.f, 0.f, 0.f};
#pragma unroll
    for (int ks = 0; ks < 2; ++ks) if (32 * ks <= 16 * qt + 15) { const bf16x8 Bp = *(const LAS bf16x8*)(PTl + iq * 72 + 32 * ks + 8 * fg);
#pragma unroll
        for (int t = 0; t < 8; ++t) { const bf16x8 A = *(const LAS bf16x8*)(VTl + (128 * dvh + 16 * t + fr) * 72 + 32 * ks + 8 * fg); acc[t] = __builtin_amdgcn_mfma_f32_16x16x32_bf16(A, Bp, acc[t], 0, 0, 0); } }
    if (SPLIT) {
#pragma unroll
        for (int e = 0; e < 8; ++e) { const int idx = tid + 512 * e, kb = idx >> 10, dv = (idx >> 2) & 255; *(LAS v4u*)(SNl + kb * 17408 + dv * 64 + (dv >> 2) * 16 + (idx & 3) * 16) = sn[e]; }
        __syncthreads(); }
    if (n > 0) {
#pragma unroll
        for (int ks = 0; ks < 4; ++ks) { const bf16x8 Bq = *(const LAS bf16x8*)(QTl + iq * 136 + 32 * ks + 8 * fg);
#pragma unroll
            for (int t = 0; t < 8; ++t) { const int dv = 128 * dvh + 16 * t + fr; const bf16x8 A = *(const LAS bf16x8*)(SNl + ks * 17408 + dv * 64 + (dv >> 2) * 16 + fg * 16); acc[t] = __builtin_amdgcn_mfma_f32_16x16x32_bf16(A, Bq, acc[t], 0, 0, 0); } } }
    float ss = 0.f;
#pragma unroll
    for (int t = 0; t < 8; ++t) ss += (acc[t][0] * acc[t][0] + acc[t][1] * acc[t][1]) + (acc[t][2] * acc[t][2] + acc[t][3] * acc[t][3]);
    ss += __shfl_xor(ss, 16); ss += __shfl_xor(ss, 32);
    if (fg == 0) red[F.wave * 16 + fr] = ss;
    __syncthreads();
    const float tot = red[(2 * qt) * 16 + fr] + red[(2 * qt + 1) * 16 + fr];
    const float rstd = 1.0f / sqrtf(tot * (1.0f / 256.0f) + RMS_EPS);
#pragma unroll
    for (int t = 0; t < 8; ++t) { const int dv0 = 128 * dvh + 16 * t + 4 * fg; const f32x4 g4 = *(const f32x4*)(gon + dv0);
        const float r0 = bflo(rw[t].x), r1 = bfhi(rw[t].x), r2 = bflo(rw[t].y), r3 = bfhi(rw[t].y);
        const float y0 = acc[t][0] * rstd * g4.x * (r0 / (1.0f + __expf(-r0))), y1 = acc[t][1] * rstd * g4.y * (r1 / (1.0f + __expf(-r1)));
        const float y2 = acc[t][2] * rstd * g4.z * (r2 / (1.0f + __expf(-r2))), y3 = acc[t][3] * rstd * g4.w * (r3 / (1.0f + __expf(-r3)));
        v2u w; w.x = pk2(y0, y1); w.y = pk2(y2, y3); *(v2u*)(mix + m * DM + h * 256 + dv0) = w; }
    __syncthreads();
}

typedef short s16x4 __attribute__((ext_vector_type(4)));
constexpr int AT_KROW = 136, AT_VROW = 144;
constexpr int AT_V_OFF = 256 * AT_KROW * 2, AT_TB_OFF = AT_V_OFF + 256 * AT_VROW * 2;
constexpr float LOG2E = 1.4426950408889634f;
struct AttnUnit { int b, h, br, cls, pb; };
__device__ const unsigned char kAttnPlan[28][8] = {
 {1,50,99,148,35,90,160,255},
 {2,51,100,149,36,91,164,255},
 {3,52,101,150,37,92,168,255},
 {4,53,102,151,38,93,172,255},
 {5,54,103,152,39,94,176,255},
 {6,55,104,153,40,95,177,255},
 {7,56,105,154,41,96,178,255},
 {8,57,106,155,42,112,179,255},
 {9,58,107,156,43,116,180,255},
 {10,59,108,157,44,120,181,255},
 {11,60,109,158,45,124,182,255},
 {12,61,110,159,46,128,183,255},
 {13,62,111,161,47,129,184,255},
 {14,63,113,162,48,130,185,255},
 {15,65,114,163,64,131,186,255},
 {17,66,115,165,68,132,187,255},
 {18,67,117,166,72,133,188,255},
 {19,69,118,167,76,134,189,255},
 {21,70,119,169,80,135,190,255},
 {22,71,121,170,81,136,191,255},
 {23,73,122,171,82,137,255,255},
 {25,74,123,173,83,138,255,255},
 {26,75,125,174,84,139,255,255},
 {27,77,126,175,85,140,255,255},
 {29,78,127,0,28,86,141,255},
 {30,79,145,16,32,87,142,255},
 {31,97,146,20,33,88,143,255},
 {49,98,147,24,34,89,144,255}};
__device__ __forceinline__ AttnUnit attn_unit_of(int bid, int it) {
    const int q = kAttnPlan[(bid - 32) >> 3][it], bh = 8 * (q / 48) + (bid & 7), rem = q % 48, br = rem >> 4, uu = rem & 15;
    AttnUnit u; u.b = bh >> 3; u.h = bh & 7; u.br = br; u.cls = br == 0 ? 0 : (br == 1 ? uu >> 2 : uu); u.pb = br == 0 ? uu : (br == 1 ? (uu & 3) : 0); return u;
}
__device__ __forceinline__ void attn_phase(const Ctx& F, const bf16* proj, const float* rel_bias, const float* mb  , bf16* OP0, bf16* OP1, bf16* OP2, float* LP) {
    const int tid = F.tid, lane = F.lane, fr = lane & 15, fg = lane >> 4, w = F.wave;
    LAS bf16* Kl = (LAS bf16*)F.lds; LAS bf16* Vl = (LAS bf16*)(F.lds + AT_V_OFF); LAS float* tb = (LAS float*)(F.lds + AT_TB_OFF);
    v4u kreg[8], vreg[8]; bf16x8 Qn[4];
#define AT_LOAD(U_) do { const int sh_ = 2 * (U_).br; const bf16* pb_ = proj + ((size_t)(U_).h * T + (size_t)(U_).b * SEQ) * 128;     \
        _Pragma("unroll") for (int e = 0; e < 8; ++e) { if (e < 4 && (U_).pb == 0) continue;     \
            const int idx = tid + 512 * e, row = idx >> 4, pc = idx & 15; const int pos = 128 * ((U_).pb - 1) + row; \
            const bf16* rp = pb_ + (size_t)((pos << sh_) + (U_).cls) * 128 + 8 * pc; kreg[e] = *(const v4u*)(rp + (size_t)8 * T * 128); vreg[e] = *(const v4u*)(rp + (size_t)16 * T * 128); } \
        { const int tq_ = ((128 * (U_).pb + 16 * w + fr) << sh_) + (U_).cls; \
          _Pragma("unroll") for (int ks = 0; ks < 4; ++ks) Qn[ks] = *(const bf16x8*)(pb_ + (size_t)tq_ * 128 + 32 * ks + 8 * fg); } } while (0)
#define AT_LOAD_PART(U_, p_) do { const int sh_ = 2 * (U_).br; const bf16* pb_ = proj + ((size_t)(U_).h * T + (size_t)(U_).b * SEQ) * 128; \
        if ((p_) < 4) { _Pragma("unroll") for (int e = 2 * (p_); e < 2 * (p_) + 2; ++e) { if (e < 4 && (U_).pb == 0) continue; \
            const int idx = tid + 512 * e, row = idx >> 4, pc = idx & 15; const int pos = 128 * ((U_).pb - 1) + row; \
            const bf16* rp = pb_ + (size_t)((pos << sh_) + (U_).cls) * 128 + 8 * pc; kreg[e] = *(const v4u*)(rp + (size_t)8 * T * 128); vreg[e] = *(const v4u*)(rp + (size_t)16 * T * 128); } } \
        else { const int tq_ = ((128 * (U_).pb + 16 * w + fr) << sh_) + (U_).cls; \
          _Pragma("unroll") for (int ks = 0; ks < 4; ++ks) Qn[ks] = *(const bf16x8*)(pb_ + (size_t)tq_ * 128 + 32 * ks + 8 * fg); } } while (0)
#define AT_STORE(U_) do { \
        _Pragma("unroll") for (int e = 0; e < 8; ++e) { if (e < 4 && (U_).pb == 0) continue; \
            const int idx = tid + 512 * e, row = idx >> 4, pc = idx & 15; *(LAS v4u*)(Kl + row * AT_KROW + 8 * pc) = kreg[e]; *(LAS v4u*)(Vl + row * AT_VROW + 8 * pc) = vreg[e]; } \
        } while (0)
    int nun = 0; for (int i = 0; i < 8; ++i) nun += kAttnPlan[(F.bid - 32) >> 3][i] != 255 ? 1 : 0;
    AttnUnit U = attn_unit_of(F.bid, 0);
    AT_LOAD(U);
    if (tid < 396) { const int hh = F.bid & 7, br_ = tid / 132, e_ = tid % 132;
        const float M = mb[hh]; float v = -INFINITY;
        if (e_ >= 1 && e_ <= 129) v = (rel_bias[kBucket[br_][e_ - 1] * 8 + hh] - M) * LOG2E;
        tb[tid] = v; }
    AT_STORE(U);
    __syncthreads();
    const unsigned tr_off = (unsigned)(((fr >> 2) + 4 * fg) * AT_VROW + 4 * (fr & 3)) * 2u;
#pragma unroll 1
    for (int it = 0; it < nun; ++it) {
        bf16x8 Qf[4];
#pragma unroll
        for (int ks = 0; ks < 4; ++ks) Qf[ks] = Qn[ks];
        const AttnUnit Un = attn_unit_of(F.bid, it + 1 < nun ? it + 1 : it);
        const bool more = it + 1 < nun;
        f32x4 O[8];
#pragma unroll
        for (int t = 0; t < 8; ++t) O[t] = (f32x4){0.f, 0.f, 0.f, 0.f};
        float lsum = 0.f;
        int a_lo = w >> 1; const int a_hi = (w >> 1) + 4; if (U.pb == 0 && a_lo < 4) a_lo = 4;
        const LAS float* tbu = tb + 132 * U.br;
        const int relc = 129 + 16 * w + fr - 4 * fg;
#pragma unroll
        for (int ai_ = 0; ai_ < 5; ++ai_) { if (more) AT_LOAD_PART(Un, ai_); __builtin_amdgcn_sched_barrier(0); const int a = (w >> 1) + ai_; if (a < a_lo) continue;
            f32x4 sa = {0.f, 0.f, 0.f, 0.f}, sb = {0.f, 0.f, 0.f, 0.f};
            const LAS bf16* kp = Kl + (32 * a + fr) * AT_KROW + 8 * fg;
#pragma unroll
            for (int ks = 0; ks < 4; ++ks) { const bf16x8 Ka = *(const LAS bf16x8*)(kp + 32 * ks), Kb = *(const LAS bf16x8*)(kp + 16 * AT_KROW + 32 * ks);
                sa = __builtin_amdgcn_mfma_f32_16x16x32_bf16(Ka, Qf[ks], sa, 0, 0, 0); sb = __builtin_amdgcn_mfma_f32_16x16x32_bf16(Kb, Qf[ks], sb, 0, 0, 0); }
            const int ia = relc - 32 * a; float pa_[4], pb_[4];
#pragma unroll
            for (int e = 0; e < 4; ++e) { int xa = ia - e, xb = ia - 16 - e; xa = xa < 0 ? 0 : (xa > 130 ? 130 : xa); xb = xb < 0 ? 0 : (xb > 130 ? 130 : xb);
                pa_[e] = __builtin_amdgcn_exp2f(sa[e] + tbu[xa]); pb_[e] = __builtin_amdgcn_exp2f(sb[e] + tbu[xb]); }
            lsum += ((pa_[0] + pa_[1]) + (pa_[2] + pa_[3])) + ((pb_[0] + pb_[1]) + (pb_[2] + pb_[3]));
            v4u pw; pw.x = pk2(pa_[0], pa_[1]); pw.y = pk2(pa_[2], pa_[3]); pw.z = pk2(pb_[0], pb_[1]); pw.w = pk2(pb_[2], pb_[3]);
            const bf16x8 Pf = __builtin_bit_cast(bf16x8, pw);
            LAS unsigned char* vb = (LAS unsigned char*)Vl + (32 * a) * (AT_VROW * 2) + tr_off;
#pragma unroll
            for (int t = 0; t < 8; ++t) {
                const s16x4 va = __builtin_bit_cast(s16x4, __builtin_amdgcn_ds_read_tr16_b64_v4i16((LAS s16x4*)(vb + 32 * t)));
                const s16x4 vb2 = __builtin_bit_cast(s16x4, __builtin_amdgcn_ds_read_tr16_b64_v4i16((LAS s16x4*)(vb + 16 * AT_VROW * 2 + 32 * t)));
                const bf16x8 Vf = {va[0], va[1], va[2], va[3], vb2[0], vb2[1], vb2[2], vb2[3]};
                O[t] = __builtin_amdgcn_mfma_f32_16x16x32_bf16(Vf, Pf, O[t], 0, 0, 0); }
        }
        lsum += __shfl_xor(lsum, 16); lsum += __shfl_xor(lsum, 32);
        {   const float inv = 1.0f / lsum; const int tq = ((128 * U.pb + 16 * w + fr) << (2 * U.br)) + U.cls; const size_t m = (size_t)U.b * SEQ + tq;
            bf16* op = (U.br == 0 ? OP0 : (U.br == 1 ? OP1 : OP2)) + m * 1024 + U.h * 128 + 4 * fg;
#pragma unroll
            for (int t = 0; t < 8; ++t) { v2u wv; wv.x = pk2(O[t][0] * inv, O[t][1] * inv); wv.y = pk2(O[t][2] * inv, O[t][3] * inv); *(v2u*)(op + 16 * t) = wv; }
            if (fg == 0) LP[((size_t)U.br * T + m) * 8 + U.h] = lsum; }
        LDS_BARRIER();
        if (it + 1 < nun) { AT_STORE(Un); LDS_BARRIER(); }
        U = Un;
    }
#undef AT_LOAD
#undef AT_LOAD_PART
#undef AT_STORE
}
__device__ __forceinline__ void attn_combine(const Ctx& F, const bf16* OP0, const bf16* OP1, const bf16* OP2, const float* LP, bf16* mix) {
    for (int i = F.bid * NTHR + F.tid; i < T * 128; i += F.G * NTHR) { const int m = i >> 7, pc = i & 127, h = pc >> 4;
        const float l0 = LP[(size_t)m * 8 + h], l1 = LP[((size_t)T + m) * 8 + h], l2 = LP[((size_t)2 * T + m) * 8 + h]; const float inv = 1.0f / (l0 + l1 + l2);
        const float w0 = l0 * inv, w1 = l1 * inv, w2 = l2 * inv;
        const v4u a = *(const v4u*)(OP0 + (size_t)m * 1024 + 8 * pc), b = *(const v4u*)(OP1 + (size_t)m * 1024 + 8 * pc), c = *(const v4u*)(OP2 + (size_t)m * 1024 + 8 * pc);
        v4u o;
        o.x = pk2(w0 * bflo(a.x) + w1 * bflo(b.x) + w2 * bflo(c.x), w0 * bfhi(a.x) + w1 * bfhi(b.x) + w2 * bfhi(c.x));
        o.y = pk2(w0 * bflo(a.y) + w1 * bflo(b.y) + w2 * bflo(c.y), w0 * bfhi(a.y) + w1 * bfhi(b.y) + w2 * bfhi(c.y));
        o.z = pk2(w0 * bflo(a.z) + w1 * bflo(b.z) + w2 * bflo(c.z), w0 * bfhi(a.z) + w1 * bfhi(b.z) + w2 * bfhi(c.z));
        o.w = pk2(w0 * bflo(a.w) + w1 * bflo(b.w) + w2 * bflo(c.w), w0 * bfhi(a.w) + w1 * bfhi(b.w) + w2 * bfhi(c.w));
        *(v4u*)(mix + (size_t)m * DM + 1024 + 8 * pc) = o; }
}

constexpr int NPHASE = 2 + 7 * DEPTH;
struct Args { const float* in[14]; float* out; unsigned char* ws; int ph_lo, ph_hi; };
#define PH_IN(k) (lo <= (k) && (k) < hi)
#define PH_END(k) do { if (PH_IN((k) + 1)) { if ((k) < 0) grid.sync(); else xcd_barrier(F.bar, (k) + 4 < NPHASE); } } while (0)
template <int L> __device__ __forceinline__ void layer_phases(const Ctx& F, const int lo, const int hi, cg::grid_group& grid) {
    constexpr int P0 = 2 + 7 * L;
    bf16* QT = (bf16*)(F.ws + WS_QT); bf16* KD = (bf16*)(F.ws + WS_KD); bf16* VT = (bf16*)(F.ws + WS_VT); bf16* PT = (bf16*)(F.ws + WS_PT); float* DEC = (float*)(F.ws + WS_DEC); bf16* SN = (bf16*)(F.ws + WS_SN);
    bf16* XB = (bf16*)(F.ws + WS_XB); bf16* PROJ = (bf16*)(F.ws + WS_PROJ); bf16* ATT = PROJ + (size_t)T * LDP;     bf16* HMID = (bf16*)(F.ws + WS_HMID); bf16* MIX = (bf16*)(F.ws + WS_MIX);
    float* SSQ = (float*)(F.ws + WS_SSQ);
    if (PH_IN(P0 + 0)) {
        pg8::Gemm g{XB, (const bf16*)(F.ws + WS_WIN + L * SZ_WIN), T, NPROJ, DM}; pg8::StaticOrder S; S.init(T, NPROJ, F.G, F.bid);
        pg8::EpiBf16<0> E{PROJ, LDP, SSQ + (2 * L) * T, C_QB / 256, C_KB / 256, C_VB / 256, F.qn_g + L * 128, F.kn_g + L * 128, 0.08838834764831845f * 1.4426950408889634f, (LAS float*)(F.lds + 131072), ATT, T};
        pg8::gemm_phase<pg8::EpiBf16<0>, pg8::StaticOrder, true, true>(F.lds, g, S, E); }
    if (PH_IN(P0 + 1)) {
        { const int it = (((F.bid >> 4) * 8 + (F.bid & 7)) << 1) | ((F.bid >> 3) & 1);
          gla_prep_item(F, it, PROJ, XB, SSQ + (2 * L) * T, (const bf16*)(F.ws + WS_WGA) + L * 16 * DM, F.gate_w2 + L * 16 * 512, F.gate_b + L * 512, QT, KD, VT, PT, DEC); }
        xcd_arrive(F.bar);
        bf16* OP0 = (bf16*)F.out; bf16* OP1 = OP0 + (size_t)T * 1024; bf16* OP2 = (bf16*)(F.ws + WS_OP2); float* LP = (float*)(F.ws + WS_LP);
        if (F.bid < 32) { xcd_wait(F.bar); gla_scan_block(F, F.bid, KD, VT, DEC, SN); }
        else { attn_phase(F, ATT, F.rel_bias, (const float*)(F.ws + WS_MB) + L * 8, OP0, OP1, OP2, LP); xcd_wait(F.bar); }

        xcd_arrive(F.bar);
        gla_out_chunk<true>(F, F.bid, PROJ, QT, VT, PT, SN, F.onorm_g + L * 256, MIX);
        gla_out_chunk<false>(F, F.bid + 256, PROJ, QT, VT, PT, SN, F.onorm_g + L * 256, MIX);
        attn_combine(F, (const bf16*)F.out, (const bf16*)F.out + (size_t)T * 1024, (const bf16*)(F.ws + WS_OP2), (const float*)(F.ws + WS_LP), MIX);
        PH_END(P0 + 3); }
    if (PH_IN(P0 + 4)) {
        pg8::Gemm g{MIX, (const bf16*)(F.ws + WS_WOUT + L * SZ_WOUT), T, DM, DM}; pg8::StaticOrder S; S.init(T, DM, F.G, F.bid);
        if (L == 0) { pg8::EpiResB<true> E{F.x, XB, XB, DM, SSQ + (2 * L + 1) * T}; pg8::gemm_phase<pg8::EpiResB<true>, pg8::StaticOrder, true, true>(F.lds, g, S, E); }
        else { pg8::EpiResB<false> E{nullptr, XB, XB, DM, SSQ + (2 * L + 1) * T}; pg8::gemm_phase<pg8::EpiResB<false>, pg8::StaticOrder, true, true>(F.lds, g, S, E); }
        PH_END(P0 + 4); }
    if (PH_IN(P0 + 5)) {
        pg8::Gemm g{XB, (const bf16*)(F.ws + WS_WGU + L * SZ_WGU), T, NGU, DM}; pg8::StaticOrder S; S.init(T, NGU, F.G, F.bid);
        pg8::EpiSwiglu E{HMID, FFN, SSQ + (2 * L + 1) * T};
        pg8::gemm_phase<pg8::EpiSwiglu, pg8::StaticOrder, true, true>(F.lds, g, S, E);
        PH_END(P0 + 5); }
    if (PH_IN(P0 + 6)) {
        pg8::Gemm g{HMID, (const bf16*)(F.ws + WS_WD + L * SZ_WD), T, DM, FFN}; pg8::StaticOrder S; S.init(T, DM, F.G, F.bid);
        if (L + 1 < DEPTH) { pg8::EpiResB<false> E{nullptr, XB, XB, DM, SSQ + (2 * L + 2) * T}; pg8::gemm_phase<pg8::EpiResB<false>, pg8::StaticOrder, true, true>(F.lds, g, S, E); }
        else { pg8::EpiResF E{XB, F.out, DM}; pg8::gemm_phase<pg8::EpiResF, pg8::StaticOrder, true, true>(F.lds, g, S, E); }
        PH_END(P0 + 6); }
}
__global__ void __launch_bounds__(NTHR, 2) fwd(Args a) {
    extern __shared__ __attribute__((aligned(16))) unsigned char lds_raw[];
#ifdef CODE_SHIFT_NOPS
    asm volatile(".rept " CODE_SHIFT_STR "\n\ts_nop 0\n\t.endr" ::: "memory");
#endif
    Ctx F;
    F.lds = (LAS unsigned char*)lds_raw; F.tid = threadIdx.x; F.lane = F.tid & 63; F.wave = __builtin_amdgcn_readfirstlane(F.tid >> 6); F.G = gridDim.x; F.bid = blockIdx.x;
    F.x = a.in[0]; F.norm1_g = a.in[1]; F.w_in = a.in[2]; F.gate_w2 = a.in[3]; F.gate_b = a.in[4]; F.onorm_g = a.in[5]; F.qn_g = a.in[6]; F.kn_g = a.in[7]; F.rel_bias = a.in[8];
    F.w_out = a.in[9]; F.norm2_g = a.in[10]; F.w_gate = a.in[11]; F.w_up = a.in[12]; F.w_down = a.in[13]; F.out = a.out; F.ws = a.ws;
    const int lo = a.ph_lo, hi = a.ph_hi;
    cg::grid_group grid = cg::this_grid();
    if (hi > NPHASE) grid.sync();
    { volatile LAS unsigned* st = (volatile LAS unsigned*)(F.lds + LDS_BYTES - 64); if (F.tid < 2) st[F.tid] = 0u; __syncthreads();
      F.bar = xcd_barrier_post((unsigned*)(F.ws + WS_CTL) + 4096, st); }
    if (PH_IN(0)) { phase_convert(F); }
    if (PH_IN(1)) { phase_norm(F, F.x, (bf16*)(F.ws + WS_XB), (float*)(F.ws + WS_SSQ)); PH_END(1); }
    layer_phases<0>(F, lo, hi, grid);
    layer_phases<1>(F, lo, hi, grid);
}

extern "C" void kernel_launch(void* const* d_in, const int* in_sizes, int n_in, void* d_out, int out_size, void* d_ws, size_t ws_size, hipStream_t stream) {
    static int grid = 0;
    if (grid == 0) {
        if (n_in != 14 || out_size != T * DM || ws_size < WS_END) { fprintf(stderr, "kernel_launch: unexpected shapes (n_in %d, out %d, ws %zu)\n", n_in, out_size, ws_size); grid = -1; return; }
        if (hipFuncSetAttribute((const void*)fwd, hipFuncAttributeMaxDynamicSharedMemorySize, LDS_BYTES) != hipSuccess) { fprintf(stderr, "kernel_launch: hipFuncSetAttribute failed\n"); grid = -1; return; }
        int dev = 0, cus = 0, per_cu = 0;
        (void)hipGetDevice(&dev); (void)hipDeviceGetAttribute(&cus, hipDeviceAttributeMultiprocessorCount, dev);
        (void)hipOccupancyMaxActiveBlocksPerMultiprocessor(&per_cu, (const void*)fwd, NTHR, LDS_BYTES);
        if (per_cu < 1 || cus < 1) { fprintf(stderr, "kernel_launch: occupancy query says %d blocks/CU on %d CUs\n", per_cu, cus); grid = -1; return; }
        if (cus < 256) { fprintf(stderr, "kernel_launch: built for a 256-CU device (found %d CUs)\n", cus); grid = -1; return; }
        grid = 256;
    }
    if (grid < 0) return;
    Args a{};
    for (int i = 0; i < 14; ++i) a.in[i] = (const float*)d_in[i];
    a.out = (float*)d_out; a.ws = (unsigned char*)d_ws; a.ph_lo = 0; a.ph_hi = NPHASE;
    if (hipMemsetAsync((char*)d_ws + WS_CTL, 0, CTL_ZERO_BYTES, stream) != hipSuccess) { fprintf(stderr, "kernel_launch: hipMemsetAsync failed\n"); return; }
    void* kargs[] = {&a};
    const hipError_t e = hipLaunchCooperativeKernel((const void*)fwd, dim3(grid), dim3(NTHR), kargs, LDS_BYTES, stream);
    if (e != hipSuccess) fprintf(stderr, "kernel_launch: cooperative launch failed: %s (grid %d)\n", hipGetErrorString(e), grid);
}
```

```cpp
#define CODE_SHIFT_NOPS 4
#define CODE_SHIFT_STR "4"
#include <hip/hip_runtime.h>
#include <hip/hip_cooperative_groups.h>
namespace cg = cooperative_groups;
#include <cstdio>
#include <cstdint>
namespace pg8 {
#define PG8_LAS __attribute__((address_space(3)))
typedef unsigned short bf16_t;
typedef short bf16x8 __attribute__((ext_vector_type(8)));
typedef float f32x4 __attribute__((ext_vector_type(4)));
typedef unsigned u32x4 __attribute__((ext_vector_type(4)));
constexpr int BM = 256, BK = 64, HALF = 128, HTB = HALF * BK * 2  , STAGE_BYTES = 8 * HTB, NXCD = 8, WGM = 8;

__host__ __device__ __forceinline__ int lds_byte(int r, int c) { const int st = (r >> 4) * 2 + (c >> 5), rr = r & 15, cc = c & 31, ob = rr * 64 + cc * 2; return st * 1024 + (ob ^ (((ob >> 9) & 1) << 5)); }
__host__ __device__ __forceinline__ void stage_rc(int b, int& R, int& C) { const int st = b / 1024, sb = b % 1024, swz = sb ^ (((sb >> 9) & 1) << 5); R = (st >> 1) * 16 + swz / 64; C = (st & 1) * 32 + (swz % 64) / 2; }
__host__ __device__ __forceinline__ int perm32(int rho) { const int n = rho >> 4, i = rho & 15; return 8 * (i >> 2) + 4 * n + (i & 3); }

struct Unit { int pm, pn; };
struct Gemm { const bf16_t* A; const bf16_t* Bt; int M, N, K; };

struct StaticOrder {
    int nM, nN, nwg, G, c;
    __host__ __device__ void init(int M, int N, int G_, int c_) { nM = M / BM; nN = N / BM; nwg = nM * nN; G = G_; c = c_; }
    __host__ __device__ bool next(int i, Unit& u) const {
        const long L = (long)i * G + c; if (L >= nwg) return false;
        int wgid = (int)L; { const int q = nwg / NXCD, r = nwg % NXCD, xcd = wgid % NXCD, off = wgid / NXCD; wgid = (xcd < r ? xcd * (q + 1) : r * (q + 1) + (xcd - r) * q) + off; }
        const int nig = WGM * nN, gid = wgid / nig, fm = gid * WGM, gsz = (nM - fm) < WGM ? (nM - fm) : WGM;
        u.pm = fm + ((wgid % nig) % gsz); u.pn = (wgid % nig) / gsz; return true;
    }
    __device__ __forceinline__ void a_ready(const Unit&) const {}
    __device__ __forceinline__ void done(const Unit&) const {}
};

__device__ __forceinline__ unsigned cvt_pk_bf16(float lo, float hi) { unsigned r; asm volatile("v_cvt_pk_bf16_f32 %0, %1, %2" : "=v"(r) : "v"(lo), "v"(hi)); return r; }
typedef float f32x2 __attribute__((ext_vector_type(2)));

template <int ACT> struct EpiBf16 {
    static constexpr bool PERM = true, AFTER_DRAIN = false;
    bf16_t* O; int ldc; const float* ssq; int qk_lo, qk_mid, qk_hi; const float* gq; const float* gk; float qscale; PG8_LAS float* xl; bf16_t* att; int att_rows;
    __device__ __forceinline__ void operator()(const f32x4 (&acc)[2][2][4][2], const Unit& u, int wr, int wc, int fr, int fq) const {
        const int row0 = u.pm * BM + wr * 64 + fr; const int col0 = u.pn * BM + wc * 32 + 8 * fq;
        const bool qk = u.pn >= qk_lo && u.pn < qk_hi;
        float rsr[2][4];
#pragma unroll
        for (int ai = 0; ai < 2; ++ai)
#pragma unroll
            for (int m = 0; m < 4; ++m) rsr[ai][m] = 1.0f / sqrtf(ssq[row0 + ai * HALF + m * 16] * (1.0f / 2048.0f) + 1e-6f);
        f32x4 g0 = {1.f, 1.f, 1.f, 1.f}, g1 = {1.f, 1.f, 1.f, 1.f};
        if (qk) {
            const float* gp = (u.pn < qk_mid ? gq : gk) + wc * 32 + 8 * fq; const float sc = u.pn < qk_mid ? qscale : 1.0f;
            g0 = *(const f32x4*)gp * sc; g1 = *(const f32x4*)(gp + 4) * sc;
#pragma unroll
            for (int ai = 0; ai < 2; ++ai)
#pragma unroll
                for (int m = 0; m < 4; ++m)
#pragma unroll
                    for (int bj = 0; bj < 2; ++bj) { const f32x4 v0 = acc[ai][bj][m][0] * rsr[ai][m], v1 = acc[ai][bj][m][1] * rsr[ai][m];
                        float s = ((v0[0] * v0[0] + v0[1] * v0[1]) + (v0[2] * v0[2] + v0[3] * v0[3])) + ((v1[0] * v1[0] + v1[1] * v1[1]) + (v1[2] * v1[2] + v1[3] * v1[3]));
                        s += __shfl_xor(s, 16); s += __shfl_xor(s, 32);
                        if (fq == 0) xl[((((wr * 2 + ai) * 4 + m) * 2 + bj) * 16 + fr) * 4 + wc] = s; }
            asm volatile("s_waitcnt lgkmcnt(0)" ::: "memory"); __builtin_amdgcn_s_barrier(); asm volatile("" ::: "memory");
        }
#pragma unroll
        for (int ai = 0; ai < 2; ++ai)
#pragma unroll
            for (int m = 0; m < 4; ++m) { const int row = row0 + ai * HALF + m * 16;
                bf16_t* rowp = u.pn < qk_lo ? O + (size_t)row * ldc + col0 : att + ((size_t)(2 * (u.pn - qk_lo)) * att_rows + row) * 128 + wc * 32 + 8 * fq;
                const size_t hstride = u.pn < qk_lo ? (size_t)HALF : (size_t)att_rows * 128;
#pragma unroll
                for (int bj = 0; bj < 2; ++bj) { float rs = rsr[ai][m];
                    if (qk) { const f32x4 p = *(const PG8_LAS f32x4*)(xl + ((((wr * 2 + ai) * 4 + m) * 2 + bj) * 16 + fr) * 4); rs *= 1.0f / sqrtf(((p[0] + p[1]) + (p[2] + p[3])) * (1.0f / 128.0f) + 1e-6f); }
                    const f32x4 v0 = acc[ai][bj][m][0] * rs * g0, v1 = acc[ai][bj][m][1] * rs * g1;
                    u32x4 w; w.x = cvt_pk_bf16(v0[0], v0[1]); w.y = cvt_pk_bf16(v0[2], v0[3]); w.z = cvt_pk_bf16(v1[0], v1[1]); w.w = cvt_pk_bf16(v1[2], v1[3]);
                    *(u32x4*)(rowp + bj * hstride) = w; } }
    }
};
template <bool BASE_F32> struct EpiResB {
    static constexpr bool PERM = true, AFTER_DRAIN = false;
    const float* basf; const bf16_t* basb; bf16_t* xb; int ldc; float* ssq;
    __device__ __forceinline__ void operator()(const f32x4 (&acc)[2][2][4][2], const Unit& u, int wr, int wc, int fr, int fq) const {
        const int row0 = u.pm * BM + wr * 64 + fr, col0 = u.pn * BM + wc * 32 + 8 * fq;
#pragma unroll
        for (int ai = 0; ai < 2; ++ai)
#pragma unroll
            for (int m = 0; m < 4; ++m) { const int row = row0 + ai * HALF + m * 16; const size_t off = (size_t)row * ldc + col0; float ss = 0.f;
#pragma unroll
                for (int bj = 0; bj < 2; ++bj) { f32x4 o0, o1;
                    if (BASE_F32) { o0 = *(const f32x4*)(basf + off + bj * HALF) + acc[ai][bj][m][0]; o1 = *(const f32x4*)(basf + off + bj * HALF + 4) + acc[ai][bj][m][1]; }
                    else { const u32x4 bw = *(const u32x4*)(basb + off + bj * HALF);
                        o0 = (f32x4){__builtin_bit_cast(float, bw.x << 16), __builtin_bit_cast(float, bw.x & 0xffff0000u), __builtin_bit_cast(float, bw.y << 16), __builtin_bit_cast(float, bw.y & 0xffff0000u)} + acc[ai][bj][m][0];
                        o1 = (f32x4){__builtin_bit_cast(float, bw.z << 16), __builtin_bit_cast(float, bw.z & 0xffff0000u), __builtin_bit_cast(float, bw.w << 16), __builtin_bit_cast(float, bw.w & 0xffff0000u)} + acc[ai][bj][m][1]; }
                    ss += ((o0[0] * o0[0] + o0[1] * o0[1]) + (o0[2] * o0[2] + o0[3] * o0[3])) + ((o1[0] * o1[0] + o1[1] * o1[1]) + (o1[2] * o1[2] + o1[3] * o1[3]));
                    u32x4 w; w.x = cvt_pk_bf16(o0[0], o0[1]); w.y = cvt_pk_bf16(o0[2], o0[3]); w.z = cvt_pk_bf16(o1[0], o1[1]); w.w = cvt_pk_bf16(o1[2], o1[3]);
                    *(u32x4*)(xb + off + bj * HALF) = w; }
                ss += __shfl_xor(ss, 16); ss += __shfl_xor(ss, 32);
                if (fq == 0) atomicAdd(ssq + row, ss);
                asm volatile("" ::: "memory"); }
    }
};
struct EpiResF {
    static constexpr bool PERM = false, AFTER_DRAIN = false;
    const bf16_t* basb; float* out; int ldc;
    __device__ __forceinline__ void operator()(const f32x4 (&acc)[2][2][4][2], const Unit& u, int wr, int wc, int fr, int fq) const {
        typedef unsigned u32x2v __attribute__((ext_vector_type(2)));
        const int row0 = u.pm * BM + wr * 64 + fr, col0 = u.pn * BM + wc * 32 + 4 * fq;
#pragma unroll
        for (int ai = 0; ai < 2; ++ai)
#pragma unroll
            for (int m = 0; m < 4; ++m) { const size_t off = (size_t)(row0 + ai * HALF + m * 16) * ldc + col0;
#pragma unroll
                for (int bj = 0; bj < 2; ++bj)
#pragma unroll
                    for (int n = 0; n < 2; ++n) { const u32x2v bw = *(const u32x2v*)(basb + off + bj * HALF + n * 16);
                        const f32x4 b = {__builtin_bit_cast(float, bw.x << 16), __builtin_bit_cast(float, bw.x & 0xffff0000u), __builtin_bit_cast(float, bw.y << 16), __builtin_bit_cast(float, bw.y & 0xffff0000u)};
                        *(f32x4*)(out + off + bj * HALF + n * 16) = b + acc[ai][bj][m][n]; }
                asm volatile("" ::: "memory"); }
    }
};
struct EpiSwiglu {
    static constexpr bool PERM = true, AFTER_DRAIN = false;
    bf16_t* O; int ldh; const float* ssq;
    __device__ __forceinline__ void operator()(const f32x4 (&acc)[2][2][4][2], const Unit& u, int wr, int wc, int fr, int fq) const {
        typedef unsigned u32x2v __attribute__((ext_vector_type(2)));
        const int row0 = u.pm * BM + wr * 64 + fr; const int h0 = u.pn * 128 + wc * 16 + 4 * fq;
#pragma unroll
        for (int ai = 0; ai < 2; ++ai)
#pragma unroll
            for (int m = 0; m < 4; ++m) { const int row = row0 + ai * HALF + m * 16; bf16_t* rowp = O + (size_t)row * ldh + h0;
                const float rs = 1.0f / sqrtf(ssq[row] * (1.0f / 2048.0f) + 1e-6f);
#pragma unroll
                for (int bj = 0; bj < 2; ++bj) { const f32x4 g = acc[ai][bj][m][0] * rs, up = acc[ai][bj][m][1] * rs; float v[4];
#pragma unroll
                    for (int e = 0; e < 4; ++e) v[e] = g[e] * __builtin_amdgcn_rcpf(1.0f + __expf(-g[e])) * up[e];
                    u32x2v w; w.x = cvt_pk_bf16(v[0], v[1]); w.y = cvt_pk_bf16(v[2], v[3]);
                    *(u32x2v*)(rowp + bj * 64) = w; } }
    }
};
template <class Epi, class Sched, bool ALIGN_EPI = false, bool SP2 = false>
__device__ __forceinline__ void gemm_phase(PG8_LAS unsigned char* lds, const Gemm g, const Sched& S, const Epi& E) {
    const int tid = threadIdx.x, wid = __builtin_amdgcn_readfirstlane(tid >> 6), lane = tid & 63, wr = wid >> 2, wc = wid & 3, fr = lane & 15, fq = lane >> 4;
    const int K = g.K, nt = K / BK;
    unsigned voffA[2], voffB[2];
#pragma unroll
    for (int i = 0; i < 2; ++i) { int R, C; stage_rc(tid * 16 + i * 8192, R, C); const int Rb = Epi::PERM ? ((R & ~31) + perm32(R & 31)) : R;
        voffA[i] = (unsigned)(R * K + C) * 2u; voffB[i] = (unsigned)(Rb * K + C) * 2u; }
    const size_t kstep = (size_t)(BK * 2);
    const size_t hstep = (size_t)HALF * K * 2;
    const size_t tstep = 2 * hstep;
    const unsigned ldsw = (unsigned)wid * 1024u;
    const int aoff = lds_byte(wr * 64 + fr, fq * 8), boff = lds_byte(wc * 32 + fr, fq * 8);
#define PG8_SA(b, h) (((b) * 2 + (h)) * HTB)
#define PG8_SB(b, h) ((4 + (b) * 2 + (h)) * HTB)
#define PG8_STAGE(bufoff, gbase, voff) do { _Pragma("unroll") for (int _i = 0; _i < 2; ++_i) \
        __builtin_amdgcn_global_load_lds((const unsigned*)((const char*)(gbase) + (voff)[_i]), (PG8_LAS unsigned*)(lds + (bufoff) + ldsw + _i * 8192), 16, 0, 0); } while (0)
#define PG8_LDA(dst, b, h) do { _Pragma("unroll") for (int m = 0; m < 4; ++m) _Pragma("unroll") for (int k = 0; k < 2; ++k) dst[m][k] = *(const PG8_LAS bf16x8*)(lds + PG8_SA(b, h) + aoff + m * 2048 + k * 1024); } while (0)
#define PG8_LDB(dst, b, h) do { _Pragma("unroll") for (int n = 0; n < 2; ++n) _Pragma("unroll") for (int k = 0; k < 2; ++k) dst[n][k] = *(const PG8_LAS bf16x8*)(lds + PG8_SB(b, h) + boff + n * 2048 + k * 1024); } while (0)
#define PG8_MMA(ai, bj, At, Bt) do { __builtin_amdgcn_s_setprio(1); _Pragma("unroll") for (int m = 0; m < 4; ++m) _Pragma("unroll") for (int n = 0; n < 2; ++n) _Pragma("unroll") for (int k = 0; k < 2; ++k) \
        acc[ai][bj][m][n] = __builtin_amdgcn_mfma_f32_16x16x32_bf16(Bt[n][k], At[m][k], acc[ai][bj][m][n], 0, 0, 0); __builtin_amdgcn_s_setprio(0); } while (0)
#define PG8_WAIT_V(n) asm volatile("s_waitcnt vmcnt(" #n ")" ::: "memory")
#define PG8_WAIT_L(n) asm volatile("s_waitcnt lgkmcnt(" #n ")" ::: "memory")
#define PG8_BAR __builtin_amdgcn_s_barrier()
#define PG8_SCHED __builtin_amdgcn_sched_barrier(0)
    Unit cur, nxt; int ui = 0;
    if (!S.next(0, cur)) return;
    f32x4 acc[2][2][4][2];
#pragma unroll
    for (int a = 0; a < 2; ++a)
#pragma unroll
        for (int b = 0; b < 2; ++b)
#pragma unroll
            for (int m = 0; m < 4; ++m)
#pragma unroll
                for (int n = 0; n < 2; ++n) acc[a][b][m][n] = (f32x4){0.f, 0.f, 0.f, 0.f};
    bf16x8 At[4][2], B0[2][2], B1[2][2];
    const char* cA = (const char*)g.A + (size_t)cur.pm * tstep; const char* cB = (const char*)g.Bt + (size_t)cur.pn * tstep;
    S.a_ready(cur);
    if constexpr (SP2) {
        PG8_STAGE(PG8_SB(0, 0), cB, voffB); PG8_STAGE(PG8_SB(0, 1), cB + hstep, voffB); PG8_STAGE(PG8_SA(0, 0), cA, voffA); PG8_STAGE(PG8_SA(0, 1), cA + hstep, voffA);
        if (wr == 1) PG8_BAR;
        PG8_WAIT_V(2); PG8_BAR;
        PG8_STAGE(PG8_SB(1, 0), cB + kstep, voffB); PG8_STAGE(PG8_SA(1, 0), cA + kstep, voffA); PG8_STAGE(PG8_SB(1, 1), cB + hstep + kstep, voffB);
        PG8_WAIT_V(6); PG8_BAR;
    } else {
        PG8_STAGE(PG8_SB(0, 0), cB, voffB); PG8_STAGE(PG8_SA(0, 0), cA, voffA); PG8_STAGE(PG8_SB(0, 1), cB + hstep, voffB); PG8_STAGE(PG8_SA(0, 1), cA + hstep, voffA);
        if (wr == 1) PG8_BAR;
        PG8_WAIT_V(4); PG8_BAR;
        PG8_STAGE(PG8_SB(1, 0), cB + kstep, voffB); PG8_STAGE(PG8_SA(1, 0), cA + kstep, voffA); PG8_STAGE(PG8_SB(1, 1), cB + hstep + kstep, voffB);
        PG8_WAIT_V(6); PG8_BAR;
    }
    for (;;) {
        const bool has_next = S.next(ui + 1, nxt);
        const char* nA = has_next ? (const char*)g.A + (size_t)nxt.pm * tstep : cA; const char* nB = has_next ? (const char*)g.Bt + (size_t)nxt.pn * tstep : cB;
        for (int t = 0; t < nt; t += 2) {
            const bool last = (t == nt - 2);
            const char* a1 = cA + (size_t)(t + 1) * kstep;
            const char* a2 = last ? nA : cA + (size_t)(t + 2) * kstep; const char* b2 = last ? nB : cB + (size_t)(t + 2) * kstep;
            const char* a3 = a2 + kstep; const char* b3 = b2 + kstep;
            if (last && has_next) S.a_ready(nxt);
            if constexpr (SP2) {
            PG8_LDB(B0, 0, 0); PG8_LDB(B1, 0, 1); PG8_SCHED; PG8_LDA(At, 0, 0); PG8_STAGE(PG8_SA(1, 1), a1 + hstep, voffA);
            PG8_WAIT_V(8); PG8_WAIT_L(0); PG8_BAR; PG8_MMA(0, 0, At, B0); PG8_MMA(0, 1, At, B1); PG8_BAR; PG8_SCHED;
            PG8_LDA(At, 0, 1); PG8_STAGE(PG8_SB(0, 0), b2, voffB); PG8_STAGE(PG8_SB(0, 1), b2 + hstep, voffB); PG8_STAGE(PG8_SA(0, 0), a2, voffA);
            PG8_WAIT_V(8); PG8_WAIT_L(0); PG8_BAR; PG8_MMA(1, 0, At, B0); PG8_MMA(1, 1, At, B1); PG8_BAR; PG8_SCHED;
            PG8_LDB(B0, 1, 0); PG8_LDB(B1, 1, 1); PG8_SCHED; PG8_LDA(At, 1, 0); PG8_STAGE(PG8_SA(0, 1), a2 + hstep, voffA);
            PG8_WAIT_V(8); PG8_WAIT_L(0); PG8_BAR; PG8_MMA(0, 0, At, B0); PG8_MMA(0, 1, At, B1); PG8_BAR; PG8_SCHED;
            PG8_LDA(At, 1, 1); PG8_STAGE(PG8_SB(1, 0), b3, voffB); PG8_STAGE(PG8_SB(1, 1), b3 + hstep, voffB); PG8_STAGE(PG8_SA(1, 0), a3, voffA);
            PG8_WAIT_V(8); PG8_WAIT_L(0); PG8_BAR; PG8_MMA(1, 0, At, B0); PG8_MMA(1, 1, At, B1); PG8_BAR; PG8_SCHED;
            } else {
            PG8_LDB(B0, 0, 0); PG8_SCHED; PG8_LDA(At, 0, 0); PG8_STAGE(PG8_SA(1, 1), a1 + hstep, voffA);
            PG8_WAIT_L(8); PG8_BAR; PG8_WAIT_L(0); PG8_MMA(0, 0, At, B0); PG8_BAR; PG8_SCHED;
            PG8_LDB(B1, 0, 1); PG8_STAGE(PG8_SB(0, 0), b2, voffB);
            PG8_BAR; PG8_WAIT_L(0); PG8_MMA(0, 1, At, B1); PG8_BAR;
            PG8_LDA(At, 0, 1); PG8_STAGE(PG8_SA(0, 0), a2, voffA);
            PG8_BAR; PG8_WAIT_L(0); PG8_MMA(1, 0, At, B0); PG8_BAR; PG8_SCHED;
            PG8_STAGE(PG8_SB(0, 1), b2 + hstep, voffB);
            PG8_WAIT_V(6); PG8_BAR; PG8_MMA(1, 1, At, B1); PG8_BAR;
            PG8_LDB(B0, 1, 0); PG8_SCHED; PG8_LDA(At, 1, 0); PG8_STAGE(PG8_SA(0, 1), a2 + hstep, voffA);
            PG8_WAIT_L(8); PG8_BAR; PG8_WAIT_L(0); PG8_MMA(0, 0, At, B0); PG8_BAR; PG8_SCHED;
            PG8_LDB(B1, 1, 1); PG8_STAGE(PG8_SB(1, 0), b3, voffB);
            PG8_BAR; PG8_WAIT_L(0); PG8_MMA(0, 1, At, B1); PG8_BAR;
            PG8_LDA(At, 1, 1); PG8_STAGE(PG8_SA(1, 0), a3, voffA);
            PG8_BAR; PG8_WAIT_L(0); PG8_MMA(1, 0, At, B0); PG8_BAR; PG8_SCHED;
            PG8_STAGE(PG8_SB(1, 1), b3 + hstep, voffB);
            PG8_WAIT_V(6); PG8_BAR; PG8_MMA(1, 1, At, B1); PG8_BAR;
            }
        }
        if constexpr (ALIGN_EPI) { if (wr == 0) PG8_BAR; }
        if constexpr (!Epi::AFTER_DRAIN) { E(acc, cur, wr, wc, fr, fq); S.done(cur); }
        if (!has_next) break;
#pragma unroll
        for (int a = 0; a < 2; ++a)
#pragma unroll
            for (int b = 0; b < 2; ++b)
#pragma unroll
                for (int m = 0; m < 4; ++m)
#pragma unroll
                    for (int n = 0; n < 2; ++n) acc[a][b][m][n] = (f32x4){0.f, 0.f, 0.f, 0.f};
        cur = nxt; cA = nA; cB = nB; ++ui;
        if constexpr (ALIGN_EPI) { if (wr == 1) PG8_BAR; }
    }
    PG8_WAIT_V(0);
    if constexpr (!ALIGN_EPI) { if (wr == 0) PG8_BAR; }
    PG8_BAR;
    if constexpr (Epi::AFTER_DRAIN) { E.fused(acc, cur, wr, wc, fr, fq, lds, wid, lane); S.done(cur); }
#undef PG8_SA
#undef PG8_SB
#undef PG8_STAGE
#undef PG8_LDA
#undef PG8_LDB
#undef PG8_MMA
#undef PG8_WAIT_V
#undef PG8_WAIT_L
#undef PG8_BAR
#undef PG8_SCHED
}
}

#define LAS __attribute__((address_space(3)))
typedef unsigned short bf16;
typedef unsigned v4u __attribute__((ext_vector_type(4)));
typedef unsigned v2u __attribute__((ext_vector_type(2)));
typedef float f32x4 __attribute__((ext_vector_type(4)));
constexpr int NWAVES = 8, NTHR = 512;
constexpr int DM = 2048, NB = 4, SEQ = 2048, T = NB * SEQ, DEPTH = 2;
constexpr int NIN = 6160, NPROJ = 6144, FFN = 5632, NGU = 2 * FFN;
constexpr int LDP = 3072;
constexpr int C_QA = 0, C_KA = 512, C_VA = 1024, C_RA = 2048, C_QB = 3072, C_KB = 4096, C_VB = 5120;
constexpr float RMS_EPS = 1e-6f;
constexpr size_t MiB = 1u << 20;
constexpr size_t WS_MB = 49152;
constexpr size_t WS_CTL = 0, CTL_ZERO_BYTES = 65536;
constexpr size_t WS_WIN = 1 * MiB, WS_WOUT = 49 * MiB, WS_WGU = 65 * MiB, WS_WD = 153 * MiB, WS_XB = 197 * MiB, WS_PROJ = 229 * MiB, WS_HMID = 229 * MiB,
                 WS_GA = 325 * MiB, WS_MIX = 326 * MiB, WS_QT = 358 * MiB, WS_KD = 366 * MiB, WS_VT = 374 * MiB, WS_PT = 390 * MiB, WS_DEC = 394 * MiB, WS_SN = 395 * MiB, WS_WGA = 427 * MiB, WS_SSQ = 428 * MiB, WS_OP2 = 429 * MiB, WS_LP = 445 * MiB, WS_END = 446 * MiB;
constexpr size_t SZ_WIN = (size_t)NPROJ * DM * 2, SZ_WOUT = (size_t)DM * DM * 2, SZ_WGU = (size_t)NGU * DM * 2, SZ_WD = (size_t)DM * FFN * 2;
static_assert(WS_WIN + 2 * SZ_WIN <= WS_WOUT && WS_WOUT + 2 * SZ_WOUT <= WS_WGU && WS_WGU + 2 * SZ_WGU <= WS_WD && WS_WD + 2 * SZ_WD <= WS_XB, "ws map (weights)");
static_assert(WS_XB + (size_t)T * DM * 2 <= WS_PROJ && WS_PROJ + (size_t)T * NPROJ * 2 <= WS_GA && WS_HMID + (size_t)T * FFN * 2 <= WS_GA && WS_GA + (size_t)T * 16 * 4 <= WS_MIX && WS_MIX + (size_t)T * DM * 2 <= WS_QT, "ws map (activations)");
constexpr int LDS_BYTES = 147456;

__device__ const unsigned char kBucket[3][129] = {
 {0,1,2,3,4,5,6,7,8,9,10,11,12,13,14,15,16,16,16,16,16,16,17,17,17,17,17,17,17,17,18,18,18,18,18,18,18,18,18,18,19,19,19,19,19,19,19,19,19,19,19,19,19,19,20,20,20,20,20,20,20,20,20,20,20,20,20,20,20,20,20,20,20,21,21,21,21,21,21,21,21,21,21,21,21,21,21,21,21,21,21,21,21,21,21,21,21,21,21,22,22,22,22,22,22,22,22,22,22,22,22,22,22,22,22,22,22,22,22,22,22,22,22,22,22,22,22,22,22},
 {0,4,8,12,16,16,17,17,18,18,19,19,19,19,20,20,20,20,20,21,21,21,21,21,21,22,22,22,22,22,22,22,22,22,23,23,23,23,23,23,23,23,23,23,23,23,24,24,24,24,24,24,24,24,24,24,24,24,24,24,24,24,25,25,25,25,25,25,25,25,25,25,25,25,25,25,25,25,25,25,25,25,25,26,26,26,26,26,26,26,26,26,26,26,26,26,26,26,26,26,26,26,26,26,26,26,26,26,26,26,26,26,26,27,27,27,27,27,27,27,27,27,27,27,27,27,27,27,27},
 {0,16,18,19,20,21,21,22,22,23,23,23,24,24,24,24,25,25,25,25,25,26,26,26,26,26,26,26,26,27,27,27,27,27,27,27,27,27,27,28,28,28,28,28,28,28,28,28,28,28,28,28,29,29,29,29,29,29,29,29,29,29,29,29,29,29,29,29,29,29,30,30,30,30,30,30,30,30,30,30,30,30,30,30,30,30,30,30,30,30,30,30,30,30,30,31,31,31,31,31,31,31,31,31,31,31,31,31,31,31,31,31,31,31,31,31,31,31,31,31,31,31,31,31,31,31,31,31,31}};

#define LDS_WAIT() asm volatile("s_waitcnt lgkmcnt(0)" ::: "memory")
#define LDS_BARRIER() do { asm volatile("s_waitcnt lgkmcnt(0)" ::: "memory"); __builtin_amdgcn_s_barrier(); asm volatile("" ::: "memory"); } while (0)
typedef float f32x2_t __attribute__((ext_vector_type(2))); typedef __bf16 bf16x2_t __attribute__((ext_vector_type(2)));
__device__ __forceinline__ unsigned pk2(float lo, float hi) { const f32x2_t v = {lo, hi}; return __builtin_bit_cast(unsigned, __builtin_convertvector(v, bf16x2_t)); }
__device__ __forceinline__ unsigned f2bf(float f) { return pk2(f, 0.f) & 0xffffu; }
__device__ __forceinline__ float bf2f(unsigned h) { return __builtin_bit_cast(float, h << 16); }
__device__ __forceinline__ float bflo(unsigned w) { return __builtin_bit_cast(float, w << 16); }
__device__ __forceinline__ float bfhi(unsigned w) { return __builtin_bit_cast(float, w & 0xffff0000u); }
__device__ __forceinline__ float wave_sum(float v) {
#pragma unroll
    for (int o = 1; o < 64; o <<= 1) v += __shfl_xor(v, o);
    return v;
}

#define XB_TMO      128
#define XB_XCNT(j)  (256  + 64 * (j))
#define XB_XSUB(j)  (1280 + 64 * (j))
#define XB_XGEN(j)  (2304 + 64 * (j))
#define XB_TOP      3328
#define XB_TOPGEN   3392
#define XCD_BAR_WORDS 3456
#define XB_SPIN_CAP (1u << 18)

__device__ __forceinline__ unsigned xb_ld(unsigned* p)              { return __hip_atomic_load(p, __ATOMIC_RELAXED, __HIP_MEMORY_SCOPE_AGENT); }
__device__ __forceinline__ unsigned xb_add(unsigned* p, unsigned v) { return __hip_atomic_fetch_add(p, v, __ATOMIC_RELAXED, __HIP_MEMORY_SCOPE_AGENT); }
__device__ __forceinline__ unsigned xb_xcc_id() { return (unsigned)__builtin_amdgcn_s_getreg((3 << 11) | 20) & 0xFu; }
#define XB_SPIN(cond, bar) do { unsigned _sp = 0; while (cond) { __builtin_amdgcn_s_sleep(1); \
    if ((++_sp & 255u) == 0u) { if (xb_ld(&(bar)[XB_TMO])) break; if (_sp > XB_SPIN_CAP) { atomicAdd(&(bar)[XB_TMO], 1u); break; } } } } while (0)

#ifndef CODE_AHEAD
#define CODE_AHEAD 32768
#endif
struct XcdBarrier {
    unsigned* bar; unsigned x;
    volatile LAS unsigned* st;
};

__device__ __forceinline__ XcdBarrier xcd_barrier_post(unsigned* bar, volatile LAS unsigned* st) {
    XcdBarrier b; b.bar = bar; b.x = xb_xcc_id(); b.st = st;
    if (threadIdx.x == 0) (void)xb_add(&bar[XB_XCNT(b.x)], 1u);
    return b;
}
__device__ __forceinline__ void xcd_barrier_complete(unsigned* bar, unsigned x, unsigned& nloc, unsigned& nx) {
    const unsigned G = gridDim.x * gridDim.y * gridDim.z;
    unsigned sum, cnt, mine, sp = 0u;
    for (;;) {
        sum = 0u; cnt = 0u; mine = 0u;
#pragma unroll
        for (unsigned j = 0; j < 16; ++j) { const unsigned c = xb_ld(&bar[XB_XCNT(j)]); sum += c; cnt += (c > 0u) ? 1u : 0u; mine = (j == x) ? c : mine; }
        if (sum == G) break;
        __builtin_amdgcn_s_sleep(1);
        if ((++sp & 255u) == 0u) { if (xb_ld(&bar[XB_TMO])) break; if (sp > XB_SPIN_CAP) { atomicAdd(&bar[XB_TMO], 1u); break; } }
    }
    nloc = mine > 0u ? mine : 1u; nx = cnt > 0u ? cnt : 1u;
}

__device__ __forceinline__ void xcd_arrive(const XcdBarrier& b) {
    asm volatile("s_waitcnt vmcnt(0)" ::: "memory");
    __syncthreads();
    if (threadIdx.x == 0) {
        unsigned* bar = b.bar;
        __builtin_amdgcn_s_waitcnt(0);
        unsigned nloc = b.st[0], nx = b.st[1];
        if (nloc == 0u) { xcd_barrier_complete(bar, b.x, nloc, nx); b.st[0] = nloc; b.st[1] = nx; }
        const unsigned old = xb_add(&bar[XB_XSUB(b.x)], 1u);
        const unsigned gen = old / nloc;
        b.st[2] = (gen + 1u) * nx;
        asm volatile("buffer_inv sc1" ::: "memory");
        if (old + 1u == (gen + 1u) * nloc) {
            __builtin_amdgcn_fence(__ATOMIC_RELEASE, "agent");
            asm volatile("s_waitcnt vmcnt(0)" ::: "memory");
            (void)xb_add(&bar[XB_TOP], 1u);
        }
    }
    {   unsigned long long pc; asm volatile("s_getpc_b64 %0" : "=s"(pc));
        if (threadIdx.x < CODE_AHEAD / 128) { const unsigned* p = (const unsigned*)(pc + (unsigned long long)threadIdx.x * 128u); unsigned v;
            asm volatile("global_load_dword %0, %1, off\n\ts_waitcnt vmcnt(0)" : "=v"(v) : "v"(p) : "memory"); } }
}
__device__ __forceinline__ void xcd_wait(const XcdBarrier& b) {
    __syncthreads();
    if (threadIdx.x == 0) {
        unsigned* bar = b.bar;
        const unsigned target = b.st[2];
        XB_SPIN((int)(xb_ld(&bar[XB_TOP]) - target) < 0, bar);
        asm volatile("s_waitcnt vmcnt(0)" ::: "memory");
    }
    __syncthreads();
}
__device__ __forceinline__ void xcd_barrier(const XcdBarrier& b) { xcd_arrive(b); xcd_wait(b); }


struct Ctx {
    LAS unsigned char* lds; int tid, lane, wave, G, bid;
    const float *x, *norm1_g, *w_in, *gate_w2, *gate_b, *onorm_g, *qn_g, *kn_g, *rel_bias, *w_out, *norm2_g, *w_gate, *w_up, *w_down;
    float* out; unsigned char* ws;
    XcdBarrier bar;
};

struct ConvItem { const float* src; bf16* dst; const float* gk; int ldw, K, mode, n0; };
__device__ __forceinline__ ConvItem conv_item_of(const Ctx& F, int it) {
    constexpr int I_IN = (DM / 128) * (NPROJ / 256), I_OUT = (DM / 128) * (DM / 256), I_G = (DM / 128) * (FFN / 256), I_D = (FFN / 128) * (DM / 256);
    constexpr int PER_LAYER = I_IN + I_OUT + 2 * I_G + I_D;
    const int l = it / PER_LAYER; int r = it % PER_LAYER; ConvItem c; c.gk = nullptr; c.mode = 0;
    if (r < I_IN) { const int nblk = NPROJ / 256, kb = r / nblk, n0 = 256 * (r % nblk); const int src0 = n0 + (n0 >= 3072 ? 16 : 0);
        c.src = F.w_in + ((size_t)l * DM + 128 * kb) * NIN + src0; c.ldw = NIN; c.dst = (bf16*)(F.ws + WS_WIN + l * SZ_WIN) + 128 * kb; c.K = DM; c.n0 = n0; c.gk = F.norm1_g + l * DM + 128 * kb; return c; }
    r -= I_IN;
    if (r < I_OUT) { const int nblk = DM / 256, kb = r / nblk, n0 = 256 * (r % nblk);
        c.src = F.w_out + ((size_t)l * DM + 128 * kb) * DM + n0; c.ldw = DM; c.dst = (bf16*)(F.ws + WS_WOUT + l * SZ_WOUT) + 128 * kb; c.K = DM; c.n0 = n0; return c; }
    r -= I_OUT;
    if (r < 2 * I_G) { const int up = r >= I_G; if (up) r -= I_G; const int nblk = FFN / 256, kb = r / nblk, n0 = 256 * (r % nblk);
        c.src = (up ? F.w_up : F.w_gate) + ((size_t)l * DM + 128 * kb) * FFN + n0; c.ldw = FFN; c.dst = (bf16*)(F.ws + WS_WGU + l * SZ_WGU) + 128 * kb; c.K = DM; c.n0 = n0; c.mode = 1 + up; c.gk = F.norm2_g + l * DM + 128 * kb; return c; }
    r -= 2 * I_G;
    { const int nblk = DM / 256, kb = r / nblk, n0 = 256 * (r % nblk);
        c.src = F.w_down + ((size_t)l * FFN + 128 * kb) * DM + n0; c.ldw = DM; c.dst = (bf16*)(F.ws + WS_WD + l * SZ_WD) + 128 * kb; c.K = FFN; c.n0 = n0; return c; }
}
__device__ __forceinline__ void conv_load(const ConvItem& c, f32x4 (&v)[16], int tid) {
    const int r8 = tid >> 6, c4 = tid & 63;
#pragma unroll
    for (int i = 0; i < 16; ++i) v[i] = *(const f32x4*)(c.src + (size_t)(8 * i + r8) * c.ldw + 4 * c4);
}
__device__ __forceinline__ void conv_store(const ConvItem& c, const f32x4 (&v)[16], LAS float* scr, int tid) {
    const int r8 = tid >> 6, c4 = tid & 63;
#pragma unroll
    for (int i = 0; i < 16; ++i) { LAS float* p = scr + (8 * i + r8) * 257 + 4 * c4; const float gs = c.gk ? c.gk[8 * i + r8] : 1.0f; p[0] = v[i].x * gs; p[1] = v[i].y * gs; p[2] = v[i].z * gs; p[3] = v[i].w * gs; }
    __syncthreads();
    const int cc = tid & 15, nr = tid >> 4;
#pragma unroll
    for (int j = 0; j < 8; ++j) { const int n = nr + 32 * j; const LAS float* sp = scr + (8 * cc) * 257 + n;
        v4u o; o.x = pk2(sp[0 * 257], sp[1 * 257]); o.y = pk2(sp[2 * 257], sp[3 * 257]); o.z = pk2(sp[4 * 257], sp[5 * 257]); o.w = pk2(sp[6 * 257], sp[7 * 257]);
        const int h = c.n0 + n; const int row = c.mode == 0 ? h : ((h >> 2) * 8 + (h & 3) + 4 * (c.mode - 1));
        *(v4u*)(c.dst + (size_t)row * c.K + 8 * cc) = o; }
    __syncthreads();
}
__device__ __forceinline__ void phase_convert(const Ctx& F) {
    LAS float* scr = (LAS float*)F.lds;
    constexpr int NITEMS = DEPTH * ((DM / 128) * (NPROJ / 256) + (DM / 128) * (DM / 256) + 2 * (DM / 128) * (FFN / 256) + (FFN / 128) * (DM / 256));
    {   f32x4 va[16], vb[16]; int it = F.bid;
        ConvItem ca = conv_item_of(F, it < NITEMS ? it : 0), cb = ca;
        if (it < NITEMS) conv_load(ca, va, F.tid);
#pragma unroll 1
        while (it < NITEMS) {
            const int itb = it + F.G; if (itb < NITEMS) { cb = conv_item_of(F, itb); conv_load(cb, vb, F.tid); }
            conv_store(ca, va, scr, F.tid);
            if (itb >= NITEMS) break;
            const int ita = itb + F.G; if (ita < NITEMS) { ca = conv_item_of(F, ita); conv_load(ca, va, F.tid); }
            conv_store(cb, vb, scr, F.tid);
            it = ita;
        }
    }
    const int gt = F.bid * NTHR + F.tid, NGT = F.G * NTHR;
    for (int i = gt; i < DEPTH * 16 * DM; i += NGT) { const int l = i / (16 * DM), j = (i / DM) & 15, k = i % DM;
        ((bf16*)(F.ws + WS_WGA))[i] = (bf16)f2bf(F.norm1_g[l * DM + k] * F.w_in[((size_t)l * DM + k) * NIN + 3072 + j]); }
    for (int i = gt; i < 4 * T; i += NGT) ((float*)(F.ws + WS_SSQ))[T + i] = 0.f;
    if (F.bid == F.G - 1) {
        LAS float* red = (LAS float*)F.lds;
        __syncthreads();
        if (F.wave < DEPTH) { const float* qg = F.qn_g + F.wave * 128; const float* kg = F.kn_g + F.wave * 128;
            float v = fmaxf(fabsf(qg[F.lane] * kg[F.lane]), fabsf(qg[F.lane + 64] * kg[F.lane + 64]));
#pragma unroll
            for (int o = 1; o < 64; o <<= 1) v = fmaxf(v, __shfl_xor(v, o));
            if (F.lane == 0) red[F.wave] = v; }
        if (F.wave == DEPTH) { const int h = F.lane & 7, kg4 = F.lane >> 3; float v = -INFINITY;
#pragma unroll
            for (int k = 0; k < 4; ++k) v = fmaxf(v, F.rel_bias[(4 * kg4 + k) * 8 + h]);
            v = fmaxf(v, __shfl_xor(v, 8)); v = fmaxf(v, __shfl_xor(v, 16)); v = fmaxf(v, __shfl_xor(v, 32));
            if (F.lane < 8) red[DEPTH + F.lane] = v; }
        __syncthreads();
        if (F.tid < DEPTH * 8) ((float*)(F.ws + WS_MB))[F.tid] = red[F.tid >> 3] * 11.313708498984761f * 1.02f + red[DEPTH + (F.tid & 7)];
    }
}

__device__ __forceinline__ void phase_norm(const Ctx& F, const float* x, bf16* xb, float* ssq) {
    const int gw = F.bid * NWAVES + F.wave, NGW = F.G * NWAVES, lane = F.lane;
    for (int m = gw; m < T; m += NGW) {
        const f32x4* xr = (const f32x4*)(x + (size_t)m * DM) + lane;
        f32x4 v[8]; float s = 0.f;
#pragma unroll
        for (int j = 0; j < 8; ++j) { v[j] = xr[64 * j]; s += (v[j].x * v[j].x + v[j].y * v[j].y) + (v[j].z * v[j].z + v[j].w * v[j].w); }
        s = wave_sum(s);
        v2u* o8 = (v2u*)(xb + (size_t)m * DM) + lane;
#pragma unroll
        for (int j = 0; j < 8; ++j) { v2u w; w.x = pk2(v[j].x, v[j].y); w.y = pk2(v[j].z, v[j].w); o8[64 * j] = w; }
        if (lane == 0) ssq[m] = s;
    }
}

typedef short bf16x8 __attribute__((ext_vector_type(8)));
constexpr int NCHUNK = NB * 4 * 32;
__device__ __forceinline__ void gla_prep_item(const Ctx& F, int item, const bf16* proj, const bf16* xb, const float* ssq, const bf16* wga, const float* w2, const float* gb, bf16* QT, bf16* KD, bf16* VT, bf16* PT, float* DEC) {
    const int b = item >> 6, n = (item >> 1) & 31, hp = item & 1, tid = F.tid, col = tid & 127, rg = tid >> 7, lane = F.lane, fr = lane & 15, fg = lane >> 4;
    const size_t m0 = (size_t)b * SEQ + n * 64;
    LAS float* GAl = (LAS float*)F.lds;
    LAS float* TOT = GAl + 1024;
    LAS bf16* Ql = (LAS bf16*)(F.lds + 6144);
    LAS bf16* Kl = (LAS bf16*)(F.lds + 23552);
    LAS bf16* Vl = (LAS bf16*)(F.lds + 40960);
    LAS float* GP = (LAS float*)(F.lds + 74752);
    v4u ql[2], kl[2], vl[4];
#define PREP_LOAD(h_) do { \
        _Pragma("unroll") for (int e = 0; e < 2; ++e) { const int idx = tid + 512 * e, row = idx >> 4, pc = idx & 15; \
            ql[e] = *(const v4u*)(proj + (m0 + row) * LDP + C_QA + (h_) * 128 + pc * 8); kl[e] = *(const v4u*)(proj + (m0 + row) * LDP + C_KA + (h_) * 128 + pc * 8); } \
        _Pragma("unroll") for (int e = 0; e < 4; ++e) { const int idx = tid + 512 * e, row = idx >> 5, pc = idx & 31; vl[e] = *(const v4u*)(proj + (m0 + row) * LDP + C_VA + (h_) * 256 + pc * 8); } } while (0)
    xcd_arrive(F.bar);
    float w2c[16]; float bias = gb[(2 * hp) * 128 + col];
#pragma unroll
    for (int j = 0; j < 16; ++j) w2c[j] = w2[j * 512 + (2 * hp) * 128 + col];
    {
        constexpr int XS = 520;
        LAS bf16* XB0 = (LAS bf16*)(F.lds + 8192); LAS bf16* XB1 = XB0 + 64 * XS;
        f32x4 gacc[4];
#pragma unroll
        for (int rt = 0; rt < 4; ++rt) gacc[rt] = (f32x4){0.f, 0.f, 0.f, 0.f};
        v4u xr[8], xq[8];
#define GA_LOAD(R_, sl_) do { _Pragma("unroll") for (int e = 0; e < 8; ++e) { const int idx = tid + 512 * e, row = idx >> 6, pc = idx & 63; R_[e] = *(const v4u*)(xb + (m0 + row) * DM + 512 * (sl_) + 8 * pc); } } while (0)
#define GA_STORE(R_, buf_) do { _Pragma("unroll") for (int e = 0; e < 8; ++e) { const int idx = tid + 512 * e, row = idx >> 6, pc = idx & 63; *(LAS v4u*)((buf_) + row * XS + 8 * pc) = R_[e]; } } while (0)
#define GA_COMP(buf_, sl_) do { _Pragma("unroll") for (int ks = 0; ks < 2; ++ks) { const int kl_ = 64 * F.wave + 32 * ks + 8 * fg; const bf16x8 B = *(const bf16x8*)(wga + fr * DM + 512 * (sl_) + kl_); \
            _Pragma("unroll") for (int rt = 0; rt < 4; ++rt) { const bf16x8 A = *(const LAS bf16x8*)((buf_) + (16 * rt + fr) * XS + kl_); gacc[rt] = __builtin_amdgcn_mfma_f32_16x16x32_bf16(A, B, gacc[rt], 0, 0, 0); } } } while (0)
        GA_LOAD(xr, 0); GA_LOAD(xq, 1); GA_STORE(xr, XB0); GA_LOAD(xr, 2); LDS_BARRIER();
        GA_COMP(XB0, 0); GA_STORE(xq, XB1); GA_LOAD(xq, 3); LDS_BARRIER();
        GA_COMP(XB1, 1); LDS_BARRIER();
        GA_STORE(xr, XB0); GA_STORE(xq, XB1);
        xcd_wait(F.bar);
        PREP_LOAD(2 * hp);
        GA_COMP(XB0, 2); GA_COMP(XB1, 3); LDS_BARRIER();
#undef GA_LOAD
#undef GA_STORE
#undef GA_COMP
#pragma unroll
        for (int rt = 0; rt < 4; ++rt)
#pragma unroll
            for (int e = 0; e < 4; ++e) GP[(F.wave * 64 + 16 * rt + 4 * fg + e) * 16 + fr] = gacc[rt][e];
        __syncthreads();
#pragma unroll
        for (int e = 0; e < 2; ++e) { const int idx = tid + 512 * e; float sum = 0.f;
#pragma unroll
            for (int w = 0; w < 8; ++w) sum += GP[w * 1024 + idx];
            GAl[idx] = sum * (1.0f / sqrtf(ssq[m0 + (idx >> 4)] * (1.0f / DM) + RMS_EPS)); }
    }
#pragma unroll 1
    for (int hh = 0; hh < 2; ++hh) {
    const int h = 2 * hp + hh, ch = (b * 4 + h) * 32 + n;
#pragma unroll
    for (int e = 0; e < 2; ++e) { const int idx = tid + 512 * e, row = idx >> 4, pc = idx & 15; *(LAS v4u*)(Ql + row * 136 + pc * 8) = ql[e]; *(LAS v4u*)(Kl + row * 136 + pc * 8) = kl[e]; }
#pragma unroll
    for (int e = 0; e < 4; ++e) { const int idx = tid + 512 * e, row = idx >> 5, pc = idx & 31; *(LAS v4u*)(Vl + row * 264 + pc * 8) = vl[e]; }
    if (hh == 0) PREP_LOAD(2 * hp + 1);
    __syncthreads();
    float pre[16]; float run = 0.f;
#pragma unroll
    for (int i = 0; i < 16; ++i) { const LAS f32x4* gr = (const LAS f32x4*)(GAl + (16 * rg + i) * 16); float gp = bias;
#pragma unroll
        for (int q = 0; q < 4; ++q) { const f32x4 gv = gr[q]; gp += gv.x * w2c[4 * q] + gv.y * w2c[4 * q + 1] + gv.z * w2c[4 * q + 2] + gv.w * w2c[4 * q + 3]; }
        run += (fminf(gp, 0.f) - __logf(1.0f + __expf(-fabsf(gp)))) * (1.0f / 16.0f); pre[i] = run; }
    TOT[rg * 128 + col] = run;
    if (hh == 0) { bias = gb[(2 * hp + 1) * 128 + col];
#pragma unroll
        for (int j = 0; j < 16; ++j) w2c[j] = w2[j * 512 + (2 * hp + 1) * 128 + col]; }
    LDS_BARRIER();
    float off = 0.f, blast = 0.f;
#pragma unroll
    for (int r4 = 0; r4 < 4; ++r4) { const float t = TOT[r4 * 128 + col]; if (r4 < rg) off += t; blast += t; }
    unsigned kdp[8];
#pragma unroll
    for (int i = 0; i < 16; i += 2) { float kd2[2];
#pragma unroll
        for (int u = 0; u < 2; ++u) { const int row = 16 * rg + i + u; const float bb = off + pre[i + u];
            const float qv = bf2f(Ql[row * 136 + col]), kv = bf2f(Kl[row * 136 + col]);
            Ql[row * 136 + col] = (bf16)f2bf(qv * 0.08838834764831845f * __expf(bb)); Kl[row * 136 + col] = (bf16)f2bf(kv * __expf(-bb)); kd2[u] = kv * __expf(blast - bb); }
        kdp[i >> 1] = pk2(kd2[0], kd2[1]); }
    { v4u* kdo = (v4u*)(KD + ((size_t)ch * 128 + col) * 64 + 16 * rg); kdo[0] = (v4u){kdp[0], kdp[1], kdp[2], kdp[3]}; kdo[1] = (v4u){kdp[4], kdp[5], kdp[6], kdp[7]}; }
    if (rg == 0) DEC[ch * 128 + col] = __expf(blast);
#pragma unroll
    for (int e = 0; e < 4; ++e) { const int idx = tid + 512 * e, dv = idx >> 3, oct = idx & 7; const LAS bf16* vp = Vl + (8 * oct) * 264 + dv;
        v4u o; o.x = (unsigned)vp[0] | ((unsigned)vp[264] << 16); o.y = (unsigned)vp[2 * 264] | ((unsigned)vp[3 * 264] << 16);
        o.z = (unsigned)vp[4 * 264] | ((unsigned)vp[5 * 264] << 16); o.w = (unsigned)vp[6 * 264] | ((unsigned)vp[7 * 264] << 16);
        *(v4u*)(VT + ((size_t)ch * 256 + dv) * 64 + 8 * oct) = o; }
    __syncthreads();
#pragma unroll
    for (int e = 0; e < 2; ++e) { const int idx = tid + 512 * e, row = idx >> 4, pc = idx & 15; *(v4u*)(QT + ((size_t)ch * 64 + row) * 128 + pc * 8) = *(const LAS v4u*)(Ql + row * 136 + pc * 8); }
    {   const int qt = F.wave >> 1;
#pragma unroll
        for (int jj = 0; jj < 2; ++jj) { const int jt = 2 * (F.wave & 1) + jj; f32x4 acc = {0.f, 0.f, 0.f, 0.f};
            if (jt <= qt) {
#pragma unroll
                for (int ks = 0; ks < 4; ++ks) { const bf16x8 A = *(const LAS bf16x8*)(Kl + (16 * jt + fr) * 136 + 32 * ks + 8 * fg), B = *(const LAS bf16x8*)(Ql + (16 * qt + fr) * 136 + 32 * ks + 8 * fg);
                    acc = __builtin_amdgcn_mfma_f32_16x16x32_bf16(A, B, acc, 0, 0, 0); } }
            const int iq = 16 * qt + fr, j0 = 16 * jt + 4 * fg;
            v2u w; w.x = pk2(j0 <= iq ? acc[0] : 0.f, j0 + 1 <= iq ? acc[1] : 0.f); w.y = pk2(j0 + 2 <= iq ? acc[2] : 0.f, j0 + 3 <= iq ? acc[3] : 0.f);
            *(v2u*)(PT + ((size_t)ch * 64 + iq) * 64 + j0) = w; } }
    __syncthreads();
    }
#undef PREP_LOAD
}
__device__ __forceinline__ void st16_wt(void* p, v4u v) { asm volatile("global_store_dwordx4 %0, %1, off sc1\n\ts_nop 2" :: "v"(p), "v"(v) : "memory"); }
constexpr int SC_ROW = 72, SC_KD_B = 128 * SC_ROW * 2, SC_VT_B = 128 * SC_ROW * 2, SC_SLOT = SC_KD_B + SC_VT_B + 512;
struct ScanRegs { v4u kd[2], vt[2], dc; };
__device__ __forceinline__ void gla_scan_block(const Ctx& F, int task, const bf16* KD, const bf16* VT, const float* DEC, bf16* SN) {
    const int bh = task >> 1, dvh = task & 1, tid = F.tid, lane = F.lane, fr = lane & 15, fg = lane >> 4, kh = F.wave >> 2, dq = F.wave & 3;
    f32x4 S[4][2];
#pragma unroll
    for (int kt = 0; kt < 4; ++kt)
#pragma unroll
        for (int dt = 0; dt < 2; ++dt) S[kt][dt] = (f32x4){0.f, 0.f, 0.f, 0.f};
#define SC_LOAD(R_, ch_) do { const int c_ = (ch_); \
        _Pragma("unroll") for (int e = 0; e < 2; ++e) R_.kd[e] = *(const v4u*)(KD + (size_t)c_ * 128 * 64 + (size_t)(tid + 512 * e) * 8); \
        _Pragma("unroll") for (int e = 0; e < 2; ++e) R_.vt[e] = *(const v4u*)(VT + ((size_t)c_ * 256 + 128 * dvh) * 64 + (size_t)(tid + 512 * e) * 8); \
        if (tid < 32) R_.dc = *(const v4u*)(DEC + (size_t)c_ * 128 + tid * 4); } while (0)
#define SC_STORE(R_, slot_) do { LAS unsigned char* sl_ = F.lds + (slot_) * SC_SLOT; \
        _Pragma("unroll") for (int e = 0; e < 2; ++e) { const int idx = tid + 512 * e; *(LAS v4u*)(sl_ + ((idx >> 3) * SC_ROW + (idx & 7) * 8) * 2) = R_.kd[e]; } \
        _Pragma("unroll") for (int e = 0; e < 2; ++e) { const int idx = tid + 512 * e; *(LAS v4u*)(sl_ + SC_KD_B + ((idx >> 3) * SC_ROW + (idx & 7) * 8) * 2) = R_.vt[e]; } \
        if (tid < 32) *(LAS v4u*)(sl_ + SC_KD_B + SC_VT_B + tid * 16) = R_.dc; } while (0)
#define SC_STEP(n_, RS_, RL_) do { const int ch = bh * 32 + (n_); \
          \
        _Pragma("unroll") for (int dt = 0; dt < 2; ++dt) _Pragma("unroll") for (int j = 0; j < 2; ++j) { v4u wv; wv.x = pk2(S[2 * j][dt][0], S[2 * j][dt][1]); wv.y = pk2(S[2 * j][dt][2], S[2 * j][dt][3]); \
            wv.z = pk2(S[2 * j + 1][dt][0], S[2 * j + 1][dt][1]); wv.w = pk2(S[2 * j + 1][dt][2], S[2 * j + 1][dt][3]); \
            st16_wt(SN + (((size_t)ch * 4 + 2 * kh + j) * 256 + 128 * dvh + 32 * dq + 16 * dt + fr) * 32 + 8 * fg, wv); } \
        if ((n_) < 31) { \
            const LAS unsigned char* sl = F.lds + ((n_) & 1) * SC_SLOT; \
            bf16x8 Bf[2][2]; \
            _Pragma("unroll") for (int dt = 0; dt < 2; ++dt) _Pragma("unroll") for (int ks = 0; ks < 2; ++ks) Bf[dt][ks] = *(const LAS bf16x8*)(sl + SC_KD_B + ((32 * dq + 16 * dt + fr) * SC_ROW + 32 * ks + 8 * fg) * 2); \
            _Pragma("unroll") for (int kt = 0; kt < 4; ++kt) {   \
                const f32x4 dd = *(const LAS f32x4*)(sl + SC_KD_B + SC_VT_B + (64 * kh + 32 * (kt >> 1) + 8 * fg + 4 * (kt & 1)) * 4); \
                const int kr = 64 * kh + 32 * (kt >> 1) + 8 * (fr >> 2) + 4 * (kt & 1) + (fr & 3); \
                const bf16x8 A0 = *(const LAS bf16x8*)(sl + (kr * SC_ROW + 8 * fg) * 2), A1 = *(const LAS bf16x8*)(sl + (kr * SC_ROW + 32 + 8 * fg) * 2); \
                _Pragma("unroll") for (int dt = 0; dt < 2; ++dt) { f32x4 sv = S[kt][dt] * dd; sv = __builtin_amdgcn_mfma_f32_16x16x32_bf16(A0, Bf[dt][0], sv, 0, 0, 0); \
                    S[kt][dt] = __builtin_amdgcn_mfma_f32_16x16x32_bf16(A1, Bf[dt][1], sv, 0, 0, 0); } } \
              \
            SC_STORE(RS_, ((n_) + 1) & 1); \
            SC_LOAD(RS_, bh * 32 + ((n_) + 3 < 31 ? (n_) + 3 : 30)); \
            LDS_BARRIER(); } } while (0)
    ScanRegs RA, RB;
    SC_LOAD(RA, bh * 32); SC_STORE(RA, 0);
    SC_LOAD(RA, bh * 32 + 1); SC_LOAD(RB, bh * 32 + 2);
    LDS_BARRIER();
#pragma unroll 1
    for (int n = 0; n < 32; n += 2) { SC_STEP(n, RA, RB); SC_STEP(n + 1, RB, RA); }
#undef SC_LOAD
#undef SC_STORE
#undef SC_STEP
    __syncthreads();
}
template <bool SPLIT> __device__ __forceinline__ void gla_out_chunk(const Ctx& F, int ch, const bf16* proj, const bf16* QT, const bf16* VT, const bf16* PT, const bf16* SN, const float* gon, bf16* mix) {
    const int bh = ch >> 5, n = ch & 31, b = bh >> 2, h = bh & 3, tid = F.tid, lane = F.lane, fr = lane & 15, fg = lane >> 4, qt = F.wave >> 1, dvh = F.wave & 1, iq = 16 * qt + fr;
    const size_t m = (size_t)b * SEQ + n * 64 + iq;
    LAS unsigned char* SNl = F.lds;
    LAS bf16* VTl = (LAS bf16*)(F.lds + 69632);
    LAS bf16* QTl = (LAS bf16*)(F.lds + 106496);
    LAS bf16* PTl = (LAS bf16*)(F.lds + 123904);
    LAS float* red = (LAS float*)(F.lds + 133120);
    v4u sn[8];
    {   v4u vt[4], q2[2], p1;
        if (!SPLIT) {
#pragma unroll
            for (int e = 0; e < 8; ++e) { const int idx = tid + 512 * e; sn[e] = *(const v4u*)(SN + (size_t)ch * 256 * 128 + (size_t)idx * 8); } }
#pragma unroll
        for (int e = 0; e < 4; ++e) { const int idx = tid + 512 * e; vt[e] = *(const v4u*)(VT + (size_t)ch * 256 * 64 + (size_t)idx * 8); }
#pragma unroll
        for (int e = 0; e < 2; ++e) { const int idx = tid + 512 * e; q2[e] = *(const v4u*)(QT + (size_t)ch * 64 * 128 + (size_t)idx * 8); }
        p1 = *(const v4u*)(PT + (size_t)ch * 64 * 64 + (size_t)tid * 8);
        if (!SPLIT) {
#pragma unroll
            for (int e = 0; e < 8; ++e) { const int idx = tid + 512 * e, kb = idx >> 10, dv = (idx >> 2) & 255; *(LAS v4u*)(SNl + kb * 17408 + dv * 64 + (dv >> 2) * 16 + (idx & 3) * 16) = sn[e]; } }
#pragma unroll
        for (int e = 0; e < 4; ++e) { const int idx = tid + 512 * e; *(LAS v4u*)(VTl + (idx >> 3) * 72 + (idx & 7) * 8) = vt[e]; }
#pragma unroll
        for (int e = 0; e < 2; ++e) { const int idx = tid + 512 * e; *(LAS v4u*)(QTl + (idx >> 4) * 136 + (idx & 15) * 8) = q2[e]; }
        *(LAS v4u*)(PTl + (tid >> 3) * 72 + (tid & 7) * 8) = p1;
    }
    v2u rw[8];
#pragma unroll
    for (int t = 0; t < 8; ++t) rw[t] = *(const v2u*)(proj + m * LDP + C_RA + h * 256 + 128 * dvh + 16 * t + 4 * fg);
    if (SPLIT) { xcd_wait(F.bar);
#pragma unroll
        for (int e = 0; e < 8; ++e) { const int idx = tid + 512 * e; sn[e] = *(const v4u*)(SN + (size_t)ch * 256 * 128 + (size_t)idx * 8); } }
    else __syncthreads();
    f32x4 acc[8];
#pragma unroll
    for (int t = 0; t < 8; ++t) acc[t] = (f32x4){0.f, 0.f, 0.f, 0.f};
#pragma unroll
    for (int ks = 0; ks < 2; ++ks) if (32 * ks <= 16 * qt + 15) { const bf16x8 Bp = *(const LAS bf16x8*)(PTl + iq * 72 + 32 * ks + 8 * fg);
#pragma unroll
        for (int t = 0; t < 8; ++t) { const bf16x8 A = *(const LAS bf16x8*)(VTl + (128 * dvh + 16 * t + fr) * 72 + 32 * ks + 8 * fg); acc[t] = __builtin_amdgcn_mfma_f32_16x16x32_bf16(A, Bp, acc[t], 0, 0, 0); } }
    if (SPLIT) {
#pragma unroll
        for (int e = 0; e < 8; ++e) { const int idx = tid + 512 * e, kb = idx >> 10, dv = (idx >> 2) & 255; *(LAS v4u*)(SNl + kb * 17408 + dv * 64 + (dv >> 2) * 16 + (idx & 3) * 16) = sn[e]; }
        __syncthreads(); }
    if (n > 0) {
#pragma unroll
        for (int ks = 0; ks < 4; ++ks) { const bf16x8 Bq = *(const LAS bf16x8*)(QTl + iq * 136 + 32 * ks + 8 * fg);
#pragma unroll
            for (int t = 0; t < 8; ++t) { const int dv = 128 * dvh + 16 * t + fr; const bf16x8 A = *(const LAS bf16x8*)(SNl + ks * 17408 + dv * 64 + (dv >> 2) * 16 + fg * 16); acc[t] = __builtin_amdgcn_mfma_f32_16x16x32_bf16(A, Bq, acc[t], 0, 0, 0); } } }
    float ss = 0.f;
#pragma unroll
    for (int t = 0; t < 8; ++t) ss += (acc[t][0] * acc[t][0] + acc[t][1] * acc[t][1]) + (acc[t][2] * acc[t][2] + acc[t][3] * acc[t][3]);
    ss += __shfl_xor(ss, 16); ss += __shfl_xor(ss, 32);
    if (fg == 0) red[F.wave * 16 + fr] = ss;
    __syncthreads();
    const float tot = red[(2 * qt) * 16 + fr] + red[(2 * qt + 1) * 16 + fr];
    const float rstd = 1.0f / sqrtf(tot * (1.0f / 256.0f) + RMS_EPS);
#pragma unroll
    for (int t = 0; t < 8; ++t) { const int dv0 = 128 * dvh + 16 * t + 4 * fg; const f32x4 g4 = *(const f32x4*)(gon + dv0);
        const float r0 = bflo(rw[t].x), r1 = bfhi(rw[t].x), r2 = bflo(rw[t].y), r3 = bfhi(rw[t].y);
        const float y0 = acc[t][0] * rstd * g4.x * (r0 / (1.0f + __expf(-r0))), y1 = acc[t][1] * rstd * g4.y * (r1 / (1.0f + __expf(-r1)));
        const float y2 = acc[t][2] * rstd * g4.z * (r2 / (1.0f + __expf(-r2))), y3 = acc[t][3] * rstd * g4.w * (r3 / (1.0f + __expf(-r3)));
        v2u w; w.x = pk2(y0, y1); w.y = pk2(y2, y3); *(v2u*)(mix + m * DM + h * 256 + dv0) = w; }
    __syncthreads();
}

typedef short s16x4 __attribute__((ext_vector_type(4)));
constexpr int AT_KROW = 136, AT_VROW = 144;
constexpr int AT_V_OFF = 256 * AT_KROW * 2, AT_TB_OFF = AT_V_OFF + 256 * AT_VROW * 2;
constexpr float LOG2E = 1.4426950408889634f;
struct AttnUnit { int b, h, br, cls, pb; };
__device__ const unsigned char kAttnPlan[28][8] = {
 {1,50,99,148,35,90,160,255},
 {2,51,100,149,36,91,164,255},
 {3,52,101,150,37,92,168,255},
 {4,53,102,151,38,93,172,255},
 {5,54,103,152,39,94,176,255},
 {6,55,104,153,40,95,177,255},
 {7,56,105,154,41,96,178,255},
 {8,57,106,155,42,112,179,255},
 {9,58,107,156,43,116,180,255},
 {10,59,108,157,44,120,181,255},
 {11,60,109,158,45,124,182,255},
 {12,61,110,159,46,128,183,255},
 {13,62,111,161,47,129,184,255},
 {14,63,113,162,48,130,185,255},
 {15,65,114,163,64,131,186,255},
 {17,66,115,165,68,132,187,255},
 {18,67,117,166,72,133,188,255},
 {19,69,118,167,76,134,189,255},
 {21,70,119,169,80,135,190,255},
 {22,71,121,170,81,136,191,255},
 {23,73,122,171,82,137,255,255},
 {25,74,123,173,83,138,255,255},
 {26,75,125,174,84,139,255,255},
 {27,77,126,175,85,140,255,255},
 {29,78,127,0,28,86,141,255},
 {30,79,145,16,32,87,142,255},
 {31,97,146,20,33,88,143,255},
 {49,98,147,24,34,89,144,255}};
__device__ __forceinline__ AttnUnit attn_unit_of(int bid, int it) {
    const int q = kAttnPlan[(bid - 32) >> 3][it], bh = 8 * (q / 48) + (bid & 7), rem = q % 48, br = rem >> 4, uu = rem & 15;
    AttnUnit u; u.b = bh >> 3; u.h = bh & 7; u.br = br; u.cls = br == 0 ? 0 : (br == 1 ? uu >> 2 : uu); u.pb = br == 0 ? uu : (br == 1 ? (uu & 3) : 0); return u;
}
__device__ __forceinline__ void attn_phase(const Ctx& F, const bf16* proj, const float* rel_bias, const float* mb  , bf16* OP0, bf16* OP1, bf16* OP2, float* LP) {
    const int tid = F.tid, lane = F.lane, fr = lane & 15, fg = lane >> 4, w = F.wave;
    LAS bf16* Kl = (LAS bf16*)F.lds; LAS bf16* Vl = (LAS bf16*)(F.lds + AT_V_OFF); LAS float* tb = (LAS float*)(F.lds + AT_TB_OFF);
    v4u kreg[8], vreg[8]; bf16x8 Qn[4];
#define AT_LOAD(U_) do { const int sh_ = 2 * (U_).br; const bf16* pb_ = proj + ((size_t)(U_).h * T + (size_t)(U_).b * SEQ) * 128;     \
        _Pragma("unroll") for (int e = 0; e < 8; ++e) { if (e < 4 && (U_).pb == 0) continue;     \
            const int idx = tid + 512 * e, row = idx >> 4, pc = idx & 15; const int pos = 128 * ((U_).pb - 1) + row; \
            const bf16* rp = pb_ + (size_t)((pos << sh_) + (U_).cls) * 128 + 8 * pc; kreg[e] = *(const v4u*)(rp + (size_t)8 * T * 128); vreg[e] = *(const v4u*)(rp + (size_t)16 * T * 128); } \
        { const int tq_ = ((128 * (U_).pb + 16 * w + fr) << sh_) + (U_).cls; \
          _Pragma("unroll") for (int ks = 0; ks < 4; ++ks) Qn[ks] = *(const bf16x8*)(pb_ + (size_t)tq_ * 128 + 32 * ks + 8 * fg); } } while (0)
#define AT_LOAD_PART(U_, p_) do { const int sh_ = 2 * (U_).br; const bf16* pb_ = proj + ((size_t)(U_).h * T + (size_t)(U_).b * SEQ) * 128; \
        if ((p_) < 4) { _Pragma("unroll") for (int e = 2 * (p_); e < 2 * (p_) + 2; ++e) { if (e < 4 && (U_).pb == 0) continue; \
            const int idx = tid + 512 * e, row = idx >> 4, pc = idx & 15; const int pos = 128 * ((U_).pb - 1) + row; \
            const bf16* rp = pb_ + (size_t)((pos << sh_) + (U_).cls) * 128 + 8 * pc; kreg[e] = *(const v4u*)(rp + (size_t)8 * T * 128); vreg[e] = *(const v4u*)(rp + (size_t)16 * T * 128); } } \
        else { const int tq_ = ((128 * (U_).pb + 16 * w + fr) << sh_) + (U_).cls; \
          _Pragma("unroll") for (int ks = 0; ks < 4; ++ks) Qn[ks] = *(const bf16x8*)(pb_ + (size_t)tq_ * 128 + 32 * ks + 8 * fg); } } while (0)
#define AT_STORE(U_) do { \
        _Pragma("unroll") for (int e = 0; e < 8; ++e) { if (e < 4 && (U_).pb == 0) continue; \
            const int idx = tid + 512 * e, row = idx >> 4, pc = idx & 15; *(LAS v4u*)(Kl + row * AT_KROW + 8 * pc) = kreg[e]; *(LAS v4u*)(Vl + row * AT_VROW + 8 * pc) = vreg[e]; } \
        } while (0)
    int nun = 0; for (int i = 0; i < 8; ++i) nun += kAttnPlan[(F.bid - 32) >> 3][i] != 255 ? 1 : 0;
    AttnUnit U = attn_unit_of(F.bid, 0);
    AT_LOAD(U);
    if (tid < 396) { const int hh = F.bid & 7, br_ = tid / 132, e_ = tid % 132;
        const float M = mb[hh]; float v = -INFINITY;
        if (e_ >= 1 && e_ <= 129) v = (rel_bias[kBucket[br_][e_ - 1] * 8 + hh] - M) * LOG2E;
        tb[tid] = v; }
    AT_STORE(U);
    __syncthreads();
    const unsigned tr_off = (unsigned)(((fr >> 2) + 4 * fg) * AT_VROW + 4 * (fr & 3)) * 2u;
#pragma unroll 1
    for (int it = 0; it < nun; ++it) {
        bf16x8 Qf[4];
#pragma unroll
        for (int ks = 0; ks < 4; ++ks) Qf[ks] = Qn[ks];
        const AttnUnit Un = attn_unit_of(F.bid, it + 1 < nun ? it + 1 : it);
        const bool more = it + 1 < nun;
        f32x4 O[8];
#pragma unroll
        for (int t = 0; t < 8; ++t) O[t] = (f32x4){0.f, 0.f, 0.f, 0.f};
        float lsum = 0.f;
        int a_lo = w >> 1; const int a_hi = (w >> 1) + 4; if (U.pb == 0 && a_lo < 4) a_lo = 4;
        const LAS float* tbu = tb + 132 * U.br;
        const int relc = 129 + 16 * w + fr - 4 * fg;
#pragma unroll
        for (int ai_ = 0; ai_ < 5; ++ai_) { if (more) AT_LOAD_PART(Un, ai_); __builtin_amdgcn_sched_barrier(0); const int a = (w >> 1) + ai_; if (a < a_lo) continue;
            f32x4 sa = {0.f, 0.f, 0.f, 0.f}, sb = {0.f, 0.f, 0.f, 0.f};
            const LAS bf16* kp = Kl + (32 * a + fr) * AT_KROW + 8 * fg;
#pragma unroll
            for (int ks = 0; ks < 4; ++ks) { const bf16x8 Ka = *(const LAS bf16x8*)(kp + 32 * ks), Kb = *(const LAS bf16x8*)(kp + 16 * AT_KROW + 32 * ks);
                sa = __builtin_amdgcn_mfma_f32_16x16x32_bf16(Ka, Qf[ks], sa, 0, 0, 0); sb = __builtin_amdgcn_mfma_f32_16x16x32_bf16(Kb, Qf[ks], sb, 0, 0, 0); }
            const int ia = relc - 32 * a; float pa_[4], pb_[4];
#pragma unroll
            for (int e = 0; e < 4; ++e) { int xa = ia - e, xb = ia - 16 - e; xa = xa < 0 ? 0 : (xa > 130 ? 130 : xa); xb = xb < 0 ? 0 : (xb > 130 ? 130 : xb);
                pa_[e] = __builtin_amdgcn_exp2f(sa[e] + tbu[xa]); pb_[e] = __builtin_amdgcn_exp2f(sb[e] + tbu[xb]); }
            lsum += ((pa_[0] + pa_[1]) + (pa_[2] + pa_[3])) + ((pb_[0] + pb_[1]) + (pb_[2] + pb_[3]));
            v4u pw; pw.x = pk2(pa_[0], pa_[1]); pw.y = pk2(pa_[2], pa_[3]); pw.z = pk2(pb_[0], pb_[1]); pw.w = pk2(pb_[2], pb_[3]);
            const bf16x8 Pf = __builtin_bit_cast(bf16x8, pw);
            LAS unsigned char* vb = (LAS unsigned char*)Vl + (32 * a) * (AT_VROW * 2) + tr_off;
#pragma unroll
            for (int t = 0; t < 8; ++t) {
                const s16x4 va = __builtin_bit_cast(s16x4, __builtin_amdgcn_ds_read_tr16_b64_v4i16((LAS s16x4*)(vb + 32 * t)));
                const s16x4 vb2 = __builtin_bit_cast(s16x4, __builtin_amdgcn_ds_read_tr16_b64_v4i16((LAS s16x4*)(vb + 16 * AT_VROW * 2 + 32 * t)));
                const bf16x8 Vf = {va[0], va[1], va[2], va[3], vb2[0], vb2[1], vb2[2], vb2[3]};
                O[t] = __builtin_amdgcn_mfma_f32_16x16x32_bf16(Vf, Pf, O[t], 0, 0, 0); }
        }
        lsum += __shfl_xor(lsum, 16); lsum += __shfl_xor(lsum, 32);
        {   const float inv = 1.0f / lsum; const int tq = ((128 * U.pb + 16 * w + fr) << (2 * U.br)) + U.cls; const size_t m = (size_t)U.b * SEQ + tq;
            bf16* op = (U.br == 0 ? OP0 : (U.br == 1 ? OP1 : OP2)) + m * 1024 + U.h * 128 + 4 * fg;
#pragma unroll
            for (int t = 0; t < 8; ++t) { v2u wv; wv.x = pk2(O[t][0] * inv, O[t][1] * inv); wv.y = pk2(O[t][2] * inv, O[t][3] * inv); *(v2u*)(op + 16 * t) = wv; }
            if (fg == 0) LP[((size_t)U.br * T + m) * 8 + U.h] = lsum; }
        LDS_BARRIER();
        if (it + 1 < nun) { AT_STORE(Un); LDS_BARRIER(); }
        U = Un;
    }
#undef AT_LOAD
#undef AT_LOAD_PART
#undef AT_STORE
}
__device__ __forceinline__ void attn_combine(const Ctx& F, const bf16* OP0, const bf16* OP1, const bf16* OP2, const float* LP, bf16* mix) {
    for (int i = F.bid * NTHR + F.tid; i < T * 128; i += F.G * NTHR) { const int m = i >> 7, pc = i & 127, h = pc >> 4;
        const float l0 = LP[(size_t)m * 8 + h], l1 = LP[((size_t)T + m) * 8 + h], l2 = LP[((size_t)2 * T + m) * 8 + h]; const float inv = 1.0f / (l0 + l1 + l2);
        const float w0 = l0 * inv, w1 = l1 * inv, w2 = l2 * inv;
        const v4u a = *(const v4u*)(OP0 + (size_t)m * 1024 + 8 * pc), b = *(const v4u*)(OP1 + (size_t)m * 1024 + 8 * pc), c = *(const v4u*)(OP2 + (size_t)m * 1024 + 8 * pc);
        v4u o;
        o.x = pk2(w0 * bflo(a.x) + w1 * bflo(b.x) + w2 * bflo(c.x), w0 * bfhi(a.x) + w1 * bfhi(b.x) + w2 * bfhi(c.x));
        o.y = pk2(w0 * bflo(a.y) + w1 * bflo(b.y) + w2 * bflo(c.y), w0 * bfhi(a.y) + w1 * bfhi(b.y) + w2 * bfhi(c.y));
        o.z = pk2(w0 * bflo(a.z) + w1 * bflo(b.z) + w2 * bflo(c.z), w0 * bfhi(a.z) + w1 * bfhi(b.z) + w2 * bfhi(c.z));
        o.w = pk2(w0 * bflo(a.w) + w1 * bflo(b.w) + w2 * bflo(c.w), w0 * bfhi(a.w) + w1 * bfhi(b.w) + w2 * bfhi(c.w));
        *(v4u*)(mix + (size_t)m * DM + 1024 + 8 * pc) = o; }
}

constexpr int NPHASE = 2 + 7 * DEPTH;
struct Args { const float* in[14]; float* out; unsigned char* ws; int ph_lo, ph_hi; };
#define PH_IN(k) (lo <= (k) && (k) < hi)
#define PH_END(k) do { if (PH_IN((k) + 1)) { if ((k) < 0) grid.sync(); else xcd_barrier(F.bar); } } while (0)
template <int L> __device__ __forceinline__ void layer_phases(const Ctx& F, const int lo, const int hi, cg::grid_group& grid) {
    constexpr int P0 = 2 + 7 * L;
    bf16* QT = (bf16*)(F.ws + WS_QT); bf16* KD = (bf16*)(F.ws + WS_KD); bf16* VT = (bf16*)(F.ws + WS_VT); bf16* PT = (bf16*)(F.ws + WS_PT); float* DEC = (float*)(F.ws + WS_DEC); bf16* SN = (bf16*)(F.ws + WS_SN);
    bf16* XB = (bf16*)(F.ws + WS_XB); bf16* PROJ = (bf16*)(F.ws + WS_PROJ); bf16* ATT = PROJ + (size_t)T * LDP;     bf16* HMID = (bf16*)(F.ws + WS_HMID); bf16* MIX = (bf16*)(F.ws + WS_MIX);
    float* SSQ = (float*)(F.ws + WS_SSQ);
    if (PH_IN(P0 + 0)) {
        pg8::Gemm g{XB, (const bf16*)(F.ws + WS_WIN + L * SZ_WIN), T, NPROJ, DM}; pg8::StaticOrder S; S.init(T, NPROJ, F.G, F.bid);
        pg8::EpiBf16<0> E{PROJ, LDP, SSQ + (2 * L) * T, C_QB / 256, C_KB / 256, C_VB / 256, F.qn_g + L * 128, F.kn_g + L * 128, 0.08838834764831845f * 1.4426950408889634f, (LAS float*)(F.lds + 131072), ATT, T};
        pg8::gemm_phase<pg8::EpiBf16<0>, pg8::StaticOrder, true, true>(F.lds, g, S, E); }
    if (PH_IN(P0 + 1)) {
        { const int it = (((F.bid >> 4) * 8 + (F.bid & 7)) << 1) | ((F.bid >> 3) & 1);
          gla_prep_item(F, it, PROJ, XB, SSQ + (2 * L) * T, (const bf16*)(F.ws + WS_WGA) + L * 16 * DM, F.gate_w2 + L * 16 * 512, F.gate_b + L * 512, QT, KD, VT, PT, DEC); }
        xcd_arrive(F.bar);
        bf16* OP0 = (bf16*)F.out; bf16* OP1 = OP0 + (size_t)T * 1024; bf16* OP2 = (bf16*)(F.ws + WS_OP2); float* LP = (float*)(F.ws + WS_LP);
        if (F.bid < 32) { xcd_wait(F.bar); gla_scan_block(F, F.bid, KD, VT, DEC, SN); }
        else { attn_phase(F, ATT, F.rel_bias, (const float*)(F.ws + WS_MB) + L * 8, OP0, OP1, OP2, LP); xcd_wait(F.bar); }

        xcd_arrive(F.bar);
        gla_out_chunk<true>(F, F.bid, PROJ, QT, VT, PT, SN, F.onorm_g + L * 256, MIX);
        gla_out_chunk<false>(F, F.bid + 256, PROJ, QT, VT, PT, SN, F.onorm_g + L * 256, MIX);
        attn_combine(F, (const bf16*)F.out, (const bf16*)F.out + (size_t)T * 1024, (const bf16*)(F.ws + WS_OP2), (const float*)(F.ws + WS_LP), MIX);
        PH_END(P0 + 3); }
    if (PH_IN(P0 + 4)) {
        pg8::Gemm g{MIX, (const bf16*)(F.ws + WS_WOUT + L * SZ_WOUT), T, DM, DM}; pg8::StaticOrder S; S.init(T, DM, F.G, F.bid);
        { pg8::EpiResB<false> E{nullptr, XB, XB, DM, SSQ + (2 * L + 1) * T}; pg8::gemm_phase<pg8::EpiResB<false>, pg8::StaticOrder, true, true>(F.lds, g, S, E); }
        PH_END(P0 + 4); }
    if (PH_IN(P0 + 5)) {
        pg8::Gemm g{XB, (const bf16*)(F.ws + WS_WGU + L * SZ_WGU), T, NGU, DM}; pg8::StaticOrder S; S.init(T, NGU, F.G, F.bid);
        pg8::EpiSwiglu E{HMID, FFN, SSQ + (2 * L + 1) * T};
        pg8::gemm_phase<pg8::EpiSwiglu, pg8::StaticOrder, true, true>(F.lds, g, S, E);
        PH_END(P0 + 5); }
    if (PH_IN(P0 + 6)) {
        pg8::Gemm g{HMID, (const bf16*)(F.ws + WS_WD + L * SZ_WD), T, DM, FFN}; pg8::StaticOrder S; S.init(T, DM, F.G, F.bid);
        if (L + 1 < DEPTH) { pg8::EpiResB<false> E{nullptr, XB, XB, DM, SSQ + (2 * L + 2) * T}; pg8::gemm_phase<pg8::EpiResB<false>, pg8::StaticOrder, true, true>(F.lds, g, S, E); }
        else { pg8::EpiResF E{XB, F.out, DM}; pg8::gemm_phase<pg8::EpiResF, pg8::StaticOrder, true, true>(F.lds, g, S, E); }
        PH_END(P0 + 6); }
}
__global__ void __launch_bounds__(NTHR, 2) fwd(Args a) {
    extern __shared__ __attribute__((aligned(16))) unsigned char lds_raw[];
#ifdef CODE_SHIFT_NOPS
    asm volatile(".rept " CODE_SHIFT_STR "\n\ts_nop 0\n\t.endr" ::: "memory");
#endif
    Ctx F;
    F.lds = (LAS unsigned char*)lds_raw; F.tid = threadIdx.x; F.lane = F.tid & 63; F.wave = __builtin_amdgcn_readfirstlane(F.tid >> 6); F.G = gridDim.x; F.bid = blockIdx.x;
    F.x = a.in[0]; F.norm1_g = a.in[1]; F.w_in = a.in[2]; F.gate_w2 = a.in[3]; F.gate_b = a.in[4]; F.onorm_g = a.in[5]; F.qn_g = a.in[6]; F.kn_g = a.in[7]; F.rel_bias = a.in[8];
    F.w_out = a.in[9]; F.norm2_g = a.in[10]; F.w_gate = a.in[11]; F.w_up = a.in[12]; F.w_down = a.in[13]; F.out = a.out; F.ws = a.ws;
    const int lo = a.ph_lo, hi = a.ph_hi;
    cg::grid_group grid = cg::this_grid();
    if (hi > NPHASE) grid.sync();
    { volatile LAS unsigned* st = (volatile LAS unsigned*)(F.lds + LDS_BYTES - 64); if (F.tid < 2) st[F.tid] = 0u; __syncthreads();
      F.bar = xcd_barrier_post((unsigned*)(F.ws + WS_CTL) + 4096, st); }
    if (PH_IN(0)) { phase_convert(F); }
    if (PH_IN(1)) { phase_norm(F, F.x, (bf16*)(F.ws + WS_XB), (float*)(F.ws + WS_SSQ)); PH_END(1); }
    layer_phases<0>(F, lo, hi, grid);
    layer_phases<1>(F, lo, hi, grid);
}

extern "C" void kernel_launch(void* const* d_in, const int* in_sizes, int n_in, void* d_out, int out_size, void* d_ws, size_t ws_size, hipStream_t stream) {
    static int grid = 0;
    if (grid == 0) {
        if (n_in != 14 || out_size != T * DM || ws_size < WS_END) { fprintf(stderr, "kernel_launch: unexpected shapes (n_in %d, out %d, ws %zu)\n", n_in, out_size, ws_size); grid = -1; return; }
        if (hipFuncSetAttribute((const void*)fwd, hipFuncAttributeMaxDynamicSharedMemorySize, LDS_BYTES) != hipSuccess) { fprintf(stderr, "kernel_launch: hipFuncSetAttribute failed\n"); grid = -1; return; }
        int dev = 0, cus = 0, per_cu = 0;
        (void)hipGetDevice(&dev); (void)hipDeviceGetAttribute(&cus, hipDeviceAttributeMultiprocessorCount, dev);
        (void)hipOccupancyMaxActiveBlocksPerMultiprocessor(&per_cu, (const void*)fwd, NTHR, LDS_BYTES);
        if (per_cu < 1 || cus < 1) { fprintf(stderr, "kernel_launch: occupancy query says %d blocks/CU on %d CUs\n", per_cu, cus); grid = -1; return; }
        if (cus < 256) { fprintf(stderr, "kernel_launch: built for a 256-CU device (found %d CUs)\n", cus); grid = -1; return; }
        grid = 256;
    }
    if (grid < 0) return;
    Args a{};
    for (int i = 0; i < 14; ++i) a.in[i] = (const float*)d_in[i];
    a.out = (float*)d_out; a.ws = (unsigned char*)d_ws; a.ph_lo = 0; a.ph_hi = NPHASE;
    if (hipMemsetAsync((char*)d_ws + WS_CTL, 0, CTL_ZERO_BYTES, stream) != hipSuccess) { fprintf(stderr, "kernel_launch: hipMemsetAsync failed\n"); return; }
    void* kargs[] = {&a};
    const hipError_t e = hipLaunchCooperativeKernel((const void*)fwd, dim3(grid), dim3(NTHR), kargs, LDS_BYTES, stream);
    if (e != hipSuccess) fprintf(stderr, "kernel_launch: cooperative launch failed: %s (grid %d)\n", hipGetErrorString(e), grid);
}
```

```cpp
#define CODE_SHIFT_NOPS 4
#define CODE_SHIFT_STR "4"
#include <hip/hip_runtime.h>
#include <hip/hip_cooperative_groups.h>
namespace cg = cooperative_groups;
#include <cstdio>
#include <cstdint>
namespace pg8 {
#define PG8_LAS __attribute__((address_space(3)))
typedef unsigned short bf16_t;
typedef short bf16x8 __attribute__((ext_vector_type(8)));
typedef float f32x4 __attribute__((ext_vector_type(4)));
typedef unsigned u32x4 __attribute__((ext_vector_type(4)));
constexpr int BM = 256, BK = 64, HALF = 128, HTB = HALF * BK * 2  , STAGE_BYTES = 8 * HTB, NXCD = 8, WGM = 8;

__host__ __device__ __forceinline__ int lds_byte(int r, int c) { const int st = (r >> 4) * 2 + (c >> 5), rr = r & 15, cc = c & 31, ob = rr * 64 + cc * 2; return st * 1024 + (ob ^ (((ob >> 9) & 1) << 5)); }
__host__ __device__ __forceinline__ void stage_rc(int b, int& R, int& C) { const int st = b / 1024, sb = b % 1024, swz = sb ^ (((sb >> 9) & 1) << 5); R = (st >> 1) * 16 + swz / 64; C = (st & 1) * 32 + (swz % 64) / 2; }
__host__ __device__ __forceinline__ int perm32(int rho) { const int n = rho >> 4, i = rho & 15; return 8 * (i >> 2) + 4 * n + (i & 3); }

struct Unit { int pm, pn; };
struct Gemm { const bf16_t* A; const bf16_t* Bt; int M, N, K; };

struct StaticOrder {
    int nM, nN, nwg, G, c;
    __host__ __device__ void init(int M, int N, int G_, int c_) { nM = M / BM; nN = N / BM; nwg = nM * nN; G = G_; c = c_; }
    __host__ __device__ bool next(int i, Unit& u) const {
        const long L = (long)i * G + c; if (L >= nwg) return false;
        int wgid = (int)L; { const int q = nwg / NXCD, r = nwg % NXCD, xcd = wgid % NXCD, off = wgid / NXCD; wgid = (xcd < r ? xcd * (q + 1) : r * (q + 1) + (xcd - r) * q) + off; }
        const int nig = WGM * nN, gid = wgid / nig, fm = gid * WGM, gsz = (nM - fm) < WGM ? (nM - fm) : WGM;
        u.pm = fm + ((wgid % nig) % gsz); u.pn = (wgid % nig) / gsz; return true;
    }
    __device__ __forceinline__ void a_ready(const Unit&) const {}
    __device__ __forceinline__ void done(const Unit&) const {}
};

__device__ __forceinline__ unsigned cvt_pk_bf16(float lo, float hi) { unsigned r; asm volatile("v_cvt_pk_bf16_f32 %0, %1, %2" : "=v"(r) : "v"(lo), "v"(hi)); return r; }
typedef float f32x2 __attribute__((ext_vector_type(2)));

template <int ACT> struct EpiBf16 {
    static constexpr bool PERM = true, AFTER_DRAIN = false;
    bf16_t* O; int ldc; const float* ssq; int qk_lo, qk_mid, qk_hi; const float* gq; const float* gk; float qscale; PG8_LAS float* xl; bf16_t* att; int att_rows;
    __device__ __forceinline__ void operator()(const f32x4 (&acc)[2][2][4][2], const Unit& u, int wr, int wc, int fr, int fq) const {
        const int row0 = u.pm * BM + wr * 64 + fr; const int col0 = u.pn * BM + wc * 32 + 8 * fq;
        const bool qk = u.pn >= qk_lo && u.pn < qk_hi;
        float rsr[2][4];
#pragma unroll
        for (int ai = 0; ai < 2; ++ai)
#pragma unroll
            for (int m = 0; m < 4; ++m) rsr[ai][m] = 1.0f / sqrtf(ssq[row0 + ai * HALF + m * 16] * (1.0f / 2048.0f) + 1e-6f);
        f32x4 g0 = {1.f, 1.f, 1.f, 1.f}, g1 = {1.f, 1.f, 1.f, 1.f};
        if (qk) {
            const float* gp = (u.pn < qk_mid ? gq : gk) + wc * 32 + 8 * fq; const float sc = u.pn < qk_mid ? qscale : 1.0f;
            g0 = *(const f32x4*)gp * sc; g1 = *(const f32x4*)(gp + 4) * sc;
#pragma unroll
            for (int ai = 0; ai < 2; ++ai)
#pragma unroll
                for (int m = 0; m < 4; ++m)
#pragma unroll
                    for (int bj = 0; bj < 2; ++bj) { const f32x4 v0 = acc[ai][bj][m][0] * rsr[ai][m], v1 = acc[ai][bj][m][1] * rsr[ai][m];
                        float s = ((v0[0] * v0[0] + v0[1] * v0[1]) + (v0[2] * v0[2] + v0[3] * v0[3])) + ((v1[0] * v1[0] + v1[1] * v1[1]) + (v1[2] * v1[2] + v1[3] * v1[3]));
                        s += __shfl_xor(s, 16); s += __shfl_xor(s, 32);
                        if (fq == 0) xl[((((wr * 2 + ai) * 4 + m) * 2 + bj) * 16 + fr) * 4 + wc] = s; }
            asm volatile("s_waitcnt lgkmcnt(0)" ::: "memory"); __builtin_amdgcn_s_barrier(); asm volatile("" ::: "memory");
        }
#pragma unroll
        for (int ai = 0; ai < 2; ++ai)
#pragma unroll
            for (int m = 0; m < 4; ++m) { const int row = row0 + ai * HALF + m * 16;
                bf16_t* rowp = u.pn < qk_lo ? O + (size_t)row * ldc + col0 : att + ((size_t)(2 * (u.pn - qk_lo)) * att_rows + row) * 128 + wc * 32 + 8 * fq;
                const size_t hstride = u.pn < qk_lo ? (size_t)HALF : (size_t)att_rows * 128;
#pragma unroll
                for (int bj = 0; bj < 2; ++bj) { float rs = rsr[ai][m];
                    if (qk) { const f32x4 p = *(const PG8_LAS f32x4*)(xl + ((((wr * 2 + ai) * 4 + m) * 2 + bj) * 16 + fr) * 4); rs *= 1.0f / sqrtf(((p[0] + p[1]) + (p[2] + p[3])) * (1.0f / 128.0f) + 1e-6f); }
                    const f32x4 v0 = acc[ai][bj][m][0] * rs * g0, v1 = acc[ai][bj][m][1] * rs * g1;
                    u32x4 w; w.x = cvt_pk_bf16(v0[0], v0[1]); w.y = cvt_pk_bf16(v0[2], v0[3]); w.z = cvt_pk_bf16(v1[0], v1[1]); w.w = cvt_pk_bf16(v1[2], v1[3]);
                    *(u32x4*)(rowp + bj * hstride) = w; } }
    }
};
template <bool BASE_F32> struct EpiResB {
    static constexpr bool PERM = true, AFTER_DRAIN = false;
    const float* basf; const bf16_t* basb; bf16_t* xb; int ldc; float* ssq;
    __device__ __forceinline__ void operator()(const f32x4 (&acc)[2][2][4][2], const Unit& u, int wr, int wc, int fr, int fq) const {
        const int row0 = u.pm * BM + wr * 64 + fr, col0 = u.pn * BM + wc * 32 + 8 * fq;
#pragma unroll
        for (int ai = 0; ai < 2; ++ai)
#pragma unroll
            for (int m = 0; m < 4; ++m) { const int row = row0 + ai * HALF + m * 16; const size_t off = (size_t)row * ldc + col0; float ss = 0.f;
#pragma unroll
                for (int bj = 0; bj < 2; ++bj) { f32x4 o0, o1;
                    if (BASE_F32) { o0 = *(const f32x4*)(basf + off + bj * HALF) + acc[ai][bj][m][0]; o1 = *(const f32x4*)(basf + off + bj * HALF + 4) + acc[ai][bj][m][1]; }
                    else { const u32x4 bw = *(const u32x4*)(basb + off + bj * HALF);
                        o0 = (f32x4){__builtin_bit_cast(float, bw.x << 16), __builtin_bit_cast(float, bw.x & 0xffff0000u), __builtin_bit_cast(float, bw.y << 16), __builtin_bit_cast(float, bw.y & 0xffff0000u)} + acc[ai][bj][m][0];
                        o1 = (f32x4){__builtin_bit_cast(float, bw.z << 16), __builtin_bit_cast(float, bw.z & 0xffff0000u), __builtin_bit_cast(float, bw.w << 16), __builtin_bit_cast(float, bw.w & 0xffff0000u)} + acc[ai][bj][m][1]; }
                    ss += ((o0[0] * o0[0] + o0[1] * o0[1]) + (o0[2] * o0[2] + o0[3] * o0[3])) + ((o1[0] * o1[0] + o1[1] * o1[1]) + (o1[2] * o1[2] + o1[3] * o1[3]));
                    u32x4 w; w.x = cvt_pk_bf16(o0[0], o0[1]); w.y = cvt_pk_bf16(o0[2], o0[3]); w.z = cvt_pk_bf16(o1[0], o1[1]); w.w = cvt_pk_bf16(o1[2], o1[3]);
                    *(u32x4*)(xb + off + bj * HALF) = w; }
                ss += __shfl_xor(ss, 16); ss += __shfl_xor(ss, 32);
                if (fq == 0) atomicAdd(ssq + row, ss);
                asm volatile("" ::: "memory"); }
    }
};
struct EpiResF {
    static constexpr bool PERM = false, AFTER_DRAIN = false;
    const bf16_t* basb; float* out; int ldc;
    __device__ __forceinline__ void operator()(const f32x4 (&acc)[2][2][4][2], const Unit& u, int wr, int wc, int fr, int fq) const {
        typedef unsigned u32x2v __attribute__((ext_vector_type(2)));
        const int row0 = u.pm * BM + wr * 64 + fr, col0 = u.pn * BM + wc * 32 + 4 * fq;
#pragma unroll
        for (int ai = 0; ai < 2; ++ai)
#pragma unroll
            for (int m = 0; m < 4; ++m) { const size_t off = (size_t)(row0 + ai * HALF + m * 16) * ldc + col0;
#pragma unroll
                for (int bj = 0; bj < 2; ++bj)
#pragma unroll
                    for (int n = 0; n < 2; ++n) { const u32x2v bw = *(const u32x2v*)(basb + off + bj * HALF + n * 16);
                        const f32x4 b = {__builtin_bit_cast(float, bw.x << 16), __builtin_bit_cast(float, bw.x & 0xffff0000u), __builtin_bit_cast(float, bw.y << 16), __builtin_bit_cast(float, bw.y & 0xffff0000u)};
                        *(f32x4*)(out + off + bj * HALF + n * 16) = b + acc[ai][bj][m][n]; }
                asm volatile("" ::: "memory"); }
    }
};
struct EpiSwiglu {
    static constexpr bool PERM = true, AFTER_DRAIN = false;
    bf16_t* O; int ldh; const float* ssq;
    __device__ __forceinline__ void operator()(const f32x4 (&acc)[2][2][4][2], const Unit& u, int wr, int wc, int fr, int fq) const {
        typedef unsigned u32x2v __attribute__((ext_vector_type(2)));
        const int row0 = u.pm * BM + wr * 64 + fr; const int h0 = u.pn * 128 + wc * 16 + 4 * fq;
#pragma unroll
        for (int ai = 0; ai < 2; ++ai)
#pragma unroll
            for (int m = 0; m < 4; ++m) { const int row = row0 + ai * HALF + m * 16; bf16_t* rowp = O + (size_t)row * ldh + h0;
                const float rs = 1.0f / sqrtf(ssq[row] * (1.0f / 2048.0f) + 1e-6f);
#pragma unroll
                for (int bj = 0; bj < 2; ++bj) { const f32x4 g = acc[ai][bj][m][0] * rs, up = acc[ai][bj][m][1] * rs; float v[4];
#pragma unroll
                    for (int e = 0; e < 4; ++e) v[e] = g[e] * __builtin_amdgcn_rcpf(1.0f + __expf(-g[e])) * up[e];
                    u32x2v w; w.x = cvt_pk_bf16(v[0], v[1]); w.y = cvt_pk_bf16(v[2], v[3]);
                    *(u32x2v*)(rowp + bj * 64) = w; } }
    }
};
template <class Epi, class Sched, bool ALIGN_EPI = false, bool SP2 = false>
__device__ __forceinline__ void gemm_phase(PG8_LAS unsigned char* lds, const Gemm g, const Sched& S, const Epi& E) {
    const int tid = threadIdx.x, wid = __builtin_amdgcn_readfirstlane(tid >> 6), lane = tid & 63, wr = wid >> 2, wc = wid & 3, fr = lane & 15, fq = lane >> 4;
    const int K = g.K, nt = K / BK;
    unsigned voffA[2], voffB[2];
#pragma unroll
    for (int i = 0; i < 2; ++i) { int R, C; stage_rc(tid * 16 + i * 8192, R, C); const int Rb = Epi::PERM ? ((R & ~31) + perm32(R & 31)) : R;
        voffA[i] = (unsigned)(R * K + C) * 2u; voffB[i] = (unsigned)(Rb * K + C) * 2u; }
    const size_t kstep = (size_t)(BK * 2);
    const size_t hstep = (size_t)HALF * K * 2;
    const size_t tstep = 2 * hstep;
    const unsigned ldsw = (unsigned)wid * 1024u;
    const int aoff = lds_byte(wr * 64 + fr, fq * 8), boff = lds_byte(wc * 32 + fr, fq * 8);
#define PG8_SA(b, h) (((b) * 2 + (h)) * HTB)
#define PG8_SB(b, h) ((4 + (b) * 2 + (h)) * HTB)
#define PG8_STAGE(bufoff, gbase, voff) do { _Pragma("unroll") for (int _i = 0; _i < 2; ++_i) \
        __builtin_amdgcn_global_load_lds((const unsigned*)((const char*)(gbase) + (voff)[_i]), (PG8_LAS unsigned*)(lds + (bufoff) + ldsw + _i * 8192), 16, 0, 0); } while (0)
#define PG8_LDA(dst, b, h) do { _Pragma("unroll") for (int m = 0; m < 4; ++m) _Pragma("unroll") for (int k = 0; k < 2; ++k) dst[m][k] = *(const PG8_LAS bf16x8*)(lds + PG8_SA(b, h) + aoff + m * 2048 + k * 1024); } while (0)
#define PG8_LDB(dst, b, h) do { _Pragma("unroll") for (int n = 0; n < 2; ++n) _Pragma("unroll") for (int k = 0; k < 2; ++k) dst[n][k] = *(const PG8_LAS bf16x8*)(lds + PG8_SB(b, h) + boff + n * 2048 + k * 1024); } while (0)
#define PG8_MMA(ai, bj, At, Bt) do { __builtin_amdgcn_s_setprio(1); _Pragma("unroll") for (int m = 0; m < 4; ++m) _Pragma("unroll") for (int n = 0; n < 2; ++n) _Pragma("unroll") for (int k = 0; k < 2; ++k) \
        acc[ai][bj][m][n] = __builtin_amdgcn_mfma_f32_16x16x32_bf16(Bt[n][k], At[m][k], acc[ai][bj][m][n], 0, 0, 0); __builtin_amdgcn_s_setprio(0); } while (0)
#define PG8_WAIT_V(n) asm volatile("s_waitcnt vmcnt(" #n ")" ::: "memory")
#define PG8_WAIT_L(n) asm volatile("s_waitcnt lgkmcnt(" #n ")" ::: "memory")
#define PG8_BAR __builtin_amdgcn_s_barrier()
#define PG8_SCHED __builtin_amdgcn_sched_barrier(0)
    Unit cur, nxt; int ui = 0;
    if (!S.next(0, cur)) return;
    f32x4 acc[2][2][4][2];
#pragma unroll
    for (int a = 0; a < 2; ++a)
#pragma unroll
        for (int b = 0; b < 2; ++b)
#pragma unroll
            for (int m = 0; m < 4; ++m)
#pragma unroll
                for (int n = 0; n < 2; ++n) acc[a][b][m][n] = (f32x4){0.f, 0.f, 0.f, 0.f};
    bf16x8 At[4][2], B0[2][2], B1[2][2];
    const char* cA = (const char*)g.A + (size_t)cur.pm * tstep; const char* cB = (const char*)g.Bt + (size_t)cur.pn * tstep;
    S.a_ready(cur);
    if constexpr (SP2) {
        PG8_STAGE(PG8_SB(0, 0), cB, voffB); PG8_STAGE(PG8_SB(0, 1), cB + hstep, voffB); PG8_STAGE(PG8_SA(0, 0), cA, voffA); PG8_STAGE(PG8_SA(0, 1), cA + hstep, voffA);
        if (wr == 1) PG8_BAR;
        PG8_WAIT_V(2); PG8_BAR;
        PG8_STAGE(PG8_SB(1, 0), cB + kstep, voffB); PG8_STAGE(PG8_SA(1, 0), cA + kstep, voffA); PG8_STAGE(PG8_SB(1, 1), cB + hstep + kstep, voffB);
        PG8_WAIT_V(6); PG8_BAR;
    } else {
        PG8_STAGE(PG8_SB(0, 0), cB, voffB); PG8_STAGE(PG8_SA(0, 0), cA, voffA); PG8_STAGE(PG8_SB(0, 1), cB + hstep, voffB); PG8_STAGE(PG8_SA(0, 1), cA + hstep, voffA);
        if (wr == 1) PG8_BAR;
        PG8_WAIT_V(4); PG8_BAR;
        PG8_STAGE(PG8_SB(1, 0), cB + kstep, voffB); PG8_STAGE(PG8_SA(1, 0), cA + kstep, voffA); PG8_STAGE(PG8_SB(1, 1), cB + hstep + kstep, voffB);
        PG8_WAIT_V(6); PG8_BAR;
    }
    for (;;) {
        const bool has_next = S.next(ui + 1, nxt);
        const char* nA = has_next ? (const char*)g.A + (size_t)nxt.pm * tstep : cA; const char* nB = has_next ? (const char*)g.Bt + (size_t)nxt.pn * tstep : cB;
        for (int t = 0; t < nt; t += 2) {
            const bool last = (t == nt - 2);
            const char* a1 = cA + (size_t)(t + 1) * kstep;
            const char* a2 = last ? nA : cA + (size_t)(t + 2) * kstep; const char* b2 = last ? nB : cB + (size_t)(t + 2) * kstep;
            const char* a3 = a2 + kstep; const char* b3 = b2 + kstep;
            if (last && has_next) S.a_ready(nxt);
            if constexpr (SP2) {
            PG8_LDB(B0, 0, 0); PG8_LDB(B1, 0, 1); PG8_SCHED; PG8_LDA(At, 0, 0); PG8_STAGE(PG8_SA(1, 1), a1 + hstep, voffA);
            PG8_WAIT_V(8); PG8_WAIT_L(0); PG8_BAR; PG8_MMA(0, 0, At, B0); PG8_MMA(0, 1, At, B1); PG8_BAR; PG8_SCHED;
            PG8_LDA(At, 0, 1); PG8_STAGE(PG8_SB(0, 0), b2, voffB); PG8_STAGE(PG8_SB(0, 1), b2 + hstep, voffB); PG8_STAGE(PG8_SA(0, 0), a2, voffA);
            PG8_WAIT_V(8); PG8_WAIT_L(0); PG8_BAR; PG8_MMA(1, 0, At, B0); PG8_MMA(1, 1, At, B1); PG8_BAR; PG8_SCHED;
            PG8_LDB(B0, 1, 0); PG8_LDB(B1, 1, 1); PG8_SCHED; PG8_LDA(At, 1, 0); PG8_STAGE(PG8_SA(0, 1), a2 + hstep, voffA);
            PG8_WAIT_V(8); PG8_WAIT_L(0); PG8_BAR; PG8_MMA(0, 0, At, B0); PG8_MMA(0, 1, At, B1); PG8_BAR; PG8_SCHED;
            PG8_LDA(At, 1, 1); PG8_STAGE(PG8_SB(1, 0), b3, voffB); PG8_STAGE(PG8_SB(1, 1), b3 + hstep, voffB); PG8_STAGE(PG8_SA(1, 0), a3, voffA);
            PG8_WAIT_V(8); PG8_WAIT_L(0); PG8_BAR; PG8_MMA(1, 0, At, B0); PG8_MMA(1, 1, At, B1); PG8_BAR; PG8_SCHED;
            } else {
            PG8_LDB(B0, 0, 0); PG8_SCHED; PG8_LDA(At, 0, 0); PG8_STAGE(PG8_SA(1, 1), a1 + hstep, voffA);
            PG8_WAIT_L(8); PG8_BAR; PG8_WAIT_L(0); PG8_MMA(0, 0, At, B0); PG8_BAR; PG8_SCHED;
            PG8_LDB(B1, 0, 1); PG8_STAGE(PG8_SB(0, 0), b2, voffB);
            PG8_BAR; PG8_WAIT_L(0); PG8_MMA(0, 1, At, B1); PG8_BAR;
            PG8_LDA(At, 0, 1); PG8_STAGE(PG8_SA(0, 0), a2, voffA);
            PG8_BAR; PG8_WAIT_L(0); PG8_MMA(1, 0, At, B0); PG8_BAR; PG8_SCHED;
            PG8_STAGE(PG8_SB(0, 1), b2 + hstep, voffB);
            PG8_WAIT_V(6); PG8_BAR; PG8_MMA(1, 1, At, B1); PG8_BAR;
            PG8_LDB(B0, 1, 0); PG8_SCHED; PG8_LDA(At, 1, 0); PG8_STAGE(PG8_SA(0, 1), a2 + hstep, voffA);
            PG8_WAIT_L(8); PG8_BAR; PG8_WAIT_L(0); PG8_MMA(0, 0, At, B0); PG8_BAR; PG8_SCHED;
            PG8_LDB(B1, 1, 1); PG8_STAGE(PG8_SB(1, 0), b3, voffB);
            PG8_BAR; PG8_WAIT_L(0); PG8_MMA(0, 1, At, B1); PG8_BAR;
            PG8_LDA(At, 1, 1); PG8_STAGE(PG8_SA(1, 0), a3, voffA);
            PG8_BAR; PG8_WAIT_L(0); PG8_MMA(1, 0, At, B0); PG8_BAR; PG8_SCHED;
            PG8_STAGE(PG8_SB(1, 1), b3 + hstep, voffB);
            PG8_WAIT_V(6); PG8_BAR; PG8_MMA(1, 1, At, B1); PG8_BAR;
            }
        }
        if constexpr (ALIGN_EPI) { if (wr == 0) PG8_BAR; }
        if constexpr (!Epi::AFTER_DRAIN) { E(acc, cur, wr, wc, fr, fq); S.done(cur); }
        if (!has_next) break;
#pragma unroll
        for (int a = 0; a < 2; ++a)
#pragma unroll
            for (int b = 0; b < 2; ++b)
#pragma unroll
                for (int m = 0; m < 4; ++m)
#pragma unroll
                    for (int n = 0; n < 2; ++n) acc[a][b][m][n] = (f32x4){0.f, 0.f, 0.f, 0.f};
        cur = nxt; cA = nA; cB = nB; ++ui;
        if constexpr (ALIGN_EPI) { if (wr == 1) PG8_BAR; }
    }
    PG8_WAIT_V(0);
    if constexpr (!ALIGN_EPI) { if (wr == 0) PG8_BAR; }
    PG8_BAR;
    if constexpr (Epi::AFTER_DRAIN) { E.fused(acc, cur, wr, wc, fr, fq, lds, wid, lane); S.done(cur); }
#undef PG8_SA
#undef PG8_SB
#undef PG8_STAGE
#undef PG8_LDA
#undef PG8_LDB
#undef PG8_MMA
#undef PG8_WAIT_V
#undef PG8_WAIT_L
#undef PG8_BAR
#undef PG8_SCHED
}
}

#define LAS __attribute__((address_space(3)))
typedef unsigned short bf16;
typedef unsigned v4u __attribute__((ext_vector_type(4)));
typedef unsigned v2u __attribute__((ext_vector_type(2)));
typedef float f32x4 __attribute__((ext_vector_type(4)));
constexpr int NWAVES = 8, NTHR = 512;
constexpr int DM = 2048, NB = 4, SEQ = 2048, T = NB * SEQ, DEPTH = 2;
constexpr int NIN = 6160, NPROJ = 6144, FFN = 5632, NGU = 2 * FFN;
constexpr int LDP = 3072;
constexpr int C_QA = 0, C_KA = 512, C_VA = 1024, C_RA = 2048, C_QB = 3072, C_KB = 4096, C_VB = 5120;
constexpr float RMS_EPS = 1e-6f;
constexpr size_t MiB = 1u << 20;
constexpr size_t WS_MB = 49152;
constexpr size_t WS_CTL = 0, CTL_ZERO_BYTES = 65536;
constexpr size_t WS_WIN = 1 * MiB, WS_WOUT = 49 * MiB, WS_WGU = 65 * MiB, WS_WD = 153 * MiB, WS_XB = 197 * MiB, WS_PROJ = 229 * MiB, WS_HMID = 229 * MiB,
                 WS_GA = 325 * MiB, WS_MIX = 326 * MiB, WS_QT = 358 * MiB, WS_KD = 366 * MiB, WS_VT = 374 * MiB, WS_PT = 390 * MiB, WS_DEC = 394 * MiB, WS_SN = 395 * MiB, WS_WGA = 427 * MiB, WS_SSQ = 428 * MiB, WS_OP2 = 429 * MiB, WS_LP = 445 * MiB, WS_END = 446 * MiB;
constexpr size_t SZ_WIN = (size_t)NPROJ * DM * 2, SZ_WOUT = (size_t)DM * DM * 2, SZ_WGU = (size_t)NGU * DM * 2, SZ_WD = (size_t)DM * FFN * 2;
static_assert(WS_WIN + 2 * SZ_WIN <= WS_WOUT && WS_WOUT + 2 * SZ_WOUT <= WS_WGU && WS_WGU + 2 * SZ_WGU <= WS_WD && WS_WD + 2 * SZ_WD <= WS_XB, "ws map (weights)");
static_assert(WS_XB + (size_t)T * DM * 2 <= WS_PROJ && WS_PROJ + (size_t)T * NPROJ * 2 <= WS_GA && WS_HMID + (size_t)T * FFN * 2 <= WS_GA && WS_GA + (size_t)T * 16 * 4 <= WS_MIX && WS_MIX + (size_t)T * DM * 2 <= WS_QT, "ws map (activations)");
constexpr int LDS_BYTES = 147456;

__device__ const unsigned char kBucket[3][129] = {
 {0,1,2,3,4,5,6,7,8,9,10,11,12,13,14,15,16,16,16,16,16,16,17,17,17,17,17,17,17,17,18,18,18,18,18,18,18,18,18,18,19,19,19,19,19,19,19,19,19,19,19,19,19,19,20,20,20,20,20,20,20,20,20,20,20,20,20,20,20,20,20,20,20,21,21,21,21,21,21,21,21,21,21,21,21,21,21,21,21,21,21,21,21,21,21,21,21,21,21,22,22,22,22,22,22,22,22,22,22,22,22,22,22,22,22,22,22,22,22,22,22,22,22,22,22,22,22,22,22},
 {0,4,8,12,16,16,17,17,18,18,19,19,19,19,20,20,20,20,20,21,21,21,21,21,21,22,22,22,22,22,22,22,22,22,23,23,23,23,23,23,23,23,23,23,23,23,24,24,24,24,24,24,24,24,24,24,24,24,24,24,24,24,25,25,25,25,25,25,25,25,25,25,25,25,25,25,25,25,25,25,25,25,25,26,26,26,26,26,26,26,26,26,26,26,26,26,26,26,26,26,26,26,26,26,26,26,26,26,26,26,26,26,26,27,27,27,27,27,27,27,27,27,27,27,27,27,27,27,27},
 {0,16,18,19,20,21,21,22,22,23,23,23,24,24,24,24,25,25,25,25,25,26,26,26,26,26,26,26,26,27,27,27,27,27,27,27,27,27,27,28,28,28,28,28,28,28,28,28,28,28,28,28,29,29,29,29,29,29,29,29,29,29,29,29,29,29,29,29,29,29,30,30,30,30,30,30,30,30,30,30,30,30,30,30,30,30,30,30,30,30,30,30,30,30,30,31,31,31,31,31,31,31,31,31,31,31,31,31,31,31,31,31,31,31,31,31,31,31,31,31,31,31,31,31,31,31,31,31,31}};

#define LDS_WAIT() asm volatile("s_waitcnt lgkmcnt(0)" ::: "memory")
#define LDS_BARRIER() do { asm volatile("s_waitcnt lgkmcnt(0)" ::: "memory"); __builtin_amdgcn_s_barrier(); asm volatile("" ::: "memory"); } while (0)
typedef float f32x2_t __attribute__((ext_vector_type(2))); typedef __bf16 bf16x2_t __attribute__((ext_vector_type(2)));
__device__ __forceinline__ unsigned pk2(float lo, float hi) { const f32x2_t v = {lo, hi}; return __builtin_bit_cast(unsigned, __builtin_convertvector(v, bf16x2_t)); }
__device__ __forceinline__ unsigned f2bf(float f) { return pk2(f, 0.f) & 0xffffu; }
__device__ __forceinline__ float bf2f(unsigned h) { return __builtin_bit_cast(float, h << 16); }
__device__ __forceinline__ float bflo(unsigned w) { return __builtin_bit_cast(float, w << 16); }
__device__ __forceinline__ float bfhi(unsigned w) { return __builtin_bit_cast(float, w & 0xffff0000u); }
__device__ __forceinline__ float wave_sum(float v) {
#pragma unroll
    for (int o = 1; o < 64; o <<= 1) v += __shfl_xor(v, o);
    return v;
}

#define XB_TMO      128
#define XB_XCNT(j)  (256  + 64 * (j))
#define XB_XSUB(j)  (1280 + 64 * (j))
#define XB_XGEN(j)  (2304 + 64 * (j))
#define XB_TOP      3328
#define XB_TOPGEN   3392
#define XCD_BAR_WORDS 3456
#define XB_SPIN_CAP (1u << 18)

__device__ __forceinline__ unsigned xb_ld(unsigned* p)              { return __hip_atomic_load(p, __ATOMIC_RELAXED, __HIP_MEMORY_SCOPE_AGENT); }
__device__ __forceinline__ unsigned xb_add(unsigned* p, unsigned v) { return __hip_atomic_fetch_add(p, v, __ATOMIC_RELAXED, __HIP_MEMORY_SCOPE_AGENT); }
__device__ __forceinline__ unsigned xb_xcc_id() { return (unsigned)__builtin_amdgcn_s_getreg((3 << 11) | 20) & 0xFu; }
#define XB_SPIN(cond, bar) do { unsigned _sp = 0; while (cond) { __builtin_amdgcn_s_sleep(1); \
    if ((++_sp & 255u) == 0u) { if (xb_ld(&(bar)[XB_TMO])) break; if (_sp > XB_SPIN_CAP) { atomicAdd(&(bar)[XB_TMO], 1u); break; } } } } while (0)

#ifndef CODE_AHEAD
#define CODE_AHEAD 32768
#endif
struct XcdBarrier {
    unsigned* bar; unsigned x;
    volatile LAS unsigned* st;
};

__device__ __forceinline__ XcdBarrier xcd_barrier_post(unsigned* bar, volatile LAS unsigned* st) {
    XcdBarrier b; b.bar = bar; b.x = xb_xcc_id(); b.st = st;
    if (threadIdx.x == 0) (void)xb_add(&bar[XB_XCNT(b.x)], 1u);
    return b;
}
__device__ __forceinline__ void xcd_barrier_complete(unsigned* bar, unsigned x, unsigned& nloc, unsigned& nx) {
    const unsigned G = gridDim.x * gridDim.y * gridDim.z;
    unsigned sum, cnt, mine, sp = 0u;
    for (;;) {
        sum = 0u; cnt = 0u; mine = 0u;
#pragma unroll
        for (unsigned j = 0; j < 16; ++j) { const unsigned c = xb_ld(&bar[XB_XCNT(j)]); sum += c; cnt += (c > 0u) ? 1u : 0u; mine = (j == x) ? c : mine; }
        if (sum == G) break;
        __builtin_amdgcn_s_sleep(1);
        if ((++sp & 255u) == 0u) { if (xb_ld(&bar[XB_TMO])) break; if (sp > XB_SPIN_CAP) { atomicAdd(&bar[XB_TMO], 1u); break; } }
    }
    nloc = mine > 0u ? mine : 1u; nx = cnt > 0u ? cnt : 1u;
}

__device__ __forceinline__ void xcd_arrive(const XcdBarrier& b) {
    asm volatile("s_waitcnt vmcnt(0)" ::: "memory");
    __syncthreads();
    if (threadIdx.x == 0) {
        unsigned* bar = b.bar;
        __builtin_amdgcn_s_waitcnt(0);
        unsigned nloc = b.st[0], nx = b.st[1];
        if (nloc == 0u) { xcd_barrier_complete(bar, b.x, nloc, nx); b.st[0] = nloc; b.st[1] = nx; }
        const unsigned old = xb_add(&bar[XB_XSUB(b.x)], 1u);
        const unsigned gen = old / nloc;
        b.st[2] = (gen + 1u) * nx;
        asm volatile("buffer_inv sc1" ::: "memory");
        if (old + 1u == (gen + 1u) * nloc) {
            __builtin_amdgcn_fence(__ATOMIC_RELEASE, "agent");
            asm volatile("s_waitcnt vmcnt(0)" ::: "memory");
            (void)xb_add(&bar[XB_TOP], 1u);
        }
    }
    {   unsigned long long pc; asm volatile("s_getpc_b64 %0" : "=s"(pc));
        if (threadIdx.x < CODE_AHEAD / 128) { const unsigned* p = (const unsigned*)(pc + (unsigned long long)threadIdx.x * 128u); unsigned v;
            asm volatile("global_load_dword %0, %1, off\n\ts_waitcnt vmcnt(0)" : "=v"(v) : "v"(p) : "memory"); } }
}
__device__ __forceinline__ void xcd_wait(const XcdBarrier& b) {
    __syncthreads();
    if (threadIdx.x == 0) {
        unsigned* bar = b.bar;
        const unsigned target = b.st[2];
        XB_SPIN((int)(xb_ld(&bar[XB_TOP]) - target) < 0, bar);
        asm volatile("s_waitcnt vmcnt(0)" ::: "memory");
    }
    __syncthreads();
}
__device__ __forceinline__ void xcd_barrier(const XcdBarrier& b) { xcd_arrive(b); xcd_wait(b); }


struct Ctx {
    LAS unsigned char* lds; int tid, lane, wave, G, bid;
    const float *x, *norm1_g, *w_in, *gate_w2, *gate_b, *onorm_g, *qn_g, *kn_g, *rel_bias, *w_out, *norm2_g, *w_gate, *w_up, *w_down;
    float* out; unsigned char* ws;
    XcdBarrier bar;
};

struct ConvItem { const float* src; bf16* dst; const float* gk; int ldw, K, mode, n0; };
__device__ __forceinline__ ConvItem conv_item_of(const Ctx& F, int it) {
    constexpr int I_IN = (DM / 128) * (NPROJ / 256), I_OUT = (DM / 128) * (DM / 256), I_G = (DM / 128) * (FFN / 256), I_D = (FFN / 128) * (DM / 256);
    constexpr int PER_LAYER = I_IN + I_OUT + 2 * I_G + I_D;
    const int l = it / PER_LAYER; int r = it % PER_LAYER; ConvItem c; c.gk = nullptr; c.mode = 0;
    if (r < I_IN) { const int nblk = NPROJ / 256, kb = r / nblk, n0 = 256 * (r % nblk); const int src0 = n0 + (n0 >= 3072 ? 16 : 0);
        c.src = F.w_in + ((size_t)l * DM + 128 * kb) * NIN + src0; c.ldw = NIN; c.dst = (bf16*)(F.ws + WS_WIN + l * SZ_WIN) + 128 * kb; c.K = DM; c.n0 = n0; c.gk = F.norm1_g + l * DM + 128 * kb; return c; }
    r -= I_IN;
    if (r < I_OUT) { const int nblk = DM / 256, kb = r / nblk, n0 = 256 * (r % nblk);
        c.src = F.w_out + ((size_t)l * DM + 128 * kb) * DM + n0; c.ldw = DM; c.dst = (bf16*)(F.ws + WS_WOUT + l * SZ_WOUT) + 128 * kb; c.K = DM; c.n0 = n0; return c; }
    r -= I_OUT;
    if (r < 2 * I_G) { const int up = r >= I_G; if (up) r -= I_G; const int nblk = FFN / 256, kb = r / nblk, n0 = 256 * (r % nblk);
        c.src = (up ? F.w_up : F.w_gate) + ((size_t)l * DM + 128 * kb) * FFN + n0; c.ldw = FFN; c.dst = (bf16*)(F.ws + WS_WGU + l * SZ_WGU) + 128 * kb; c.K = DM; c.n0 = n0; c.mode = 1 + up; c.gk = F.norm2_g + l * DM + 128 * kb; return c; }
    r -= 2 * I_G;
    { const int nblk = DM / 256, kb = r / nblk, n0 = 256 * (r % nblk);
        c.src = F.w_down + ((size_t)l * FFN + 128 * kb) * DM + n0; c.ldw = DM; c.dst = (bf16*)(F.ws + WS_WD + l * SZ_WD) + 128 * kb; c.K = FFN; c.n0 = n0; return c; }
}
__device__ __forceinline__ void conv_load(const ConvItem& c, f32x4 (&v)[16], int tid) {
    const int r8 = tid >> 6, c4 = tid & 63;
#pragma unroll
    for (int i = 0; i < 16; ++i) v[i] = *(const f32x4*)(c.src + (size_t)(8 * i + r8) * c.ldw + 4 * c4);
}
__device__ __forceinline__ void conv_store(const ConvItem& c, const f32x4 (&v)[16], LAS float* scr, int tid) {
    const int r8 = tid >> 6, c4 = tid & 63;
#pragma unroll
    for (int i = 0; i < 16; ++i) { LAS float* p = scr + (8 * i + r8) * 257 + 4 * c4; const float gs = c.gk ? c.gk[8 * i + r8] : 1.0f; p[0] = v[i].x * gs; p[1] = v[i].y * gs; p[2] = v[i].z * gs; p[3] = v[i].w * gs; }
    __syncthreads();
    const int cc = tid & 15, nr = tid >> 4;
#pragma unroll
    for (int j = 0; j < 8; ++j) { const int n = nr + 32 * j; const LAS float* sp = scr + (8 * cc) * 257 + n;
        v4u o; o.x = pk2(sp[0 * 257], sp[1 * 257]); o.y = pk2(sp[2 * 257], sp[3 * 257]); o.z = pk2(sp[4 * 257], sp[5 * 257]); o.w = pk2(sp[6 * 257], sp[7 * 257]);
        const int h = c.n0 + n; const int row = c.mode == 0 ? h : ((h >> 2) * 8 + (h & 3) + 4 * (c.mode - 1));
        *(v4u*)(c.dst + (size_t)row * c.K + 8 * cc) = o; }
    __syncthreads();
}
__device__ __forceinline__ void phase_convert(const Ctx& F) {
    LAS float* scr = (LAS float*)F.lds;
    constexpr int NITEMS = DEPTH * ((DM / 128) * (NPROJ / 256) + (DM / 128) * (DM / 256) + 2 * (DM / 128) * (FFN / 256) + (FFN / 128) * (DM / 256));
    {   f32x4 va[16], vb[16]; int it = F.bid;
        ConvItem ca = conv_item_of(F, it < NITEMS ? it : 0), cb = ca;
        if (it < NITEMS) conv_load(ca, va, F.tid);
#pragma unroll 1
        while (it < NITEMS) {
            const int itb = it + F.G; if (itb < NITEMS) { cb = conv_item_of(F, itb); conv_load(cb, vb, F.tid); }
            conv_store(ca, va, scr, F.tid);
            if (itb >= NITEMS) break;
            const int ita = itb + F.G; if (ita < NITEMS) { ca = conv_item_of(F, ita); conv_load(ca, va, F.tid); }
            conv_store(cb, vb, scr, F.tid);
            it = ita;
        }
    }
    const int gt = F.bid * NTHR + F.tid, NGT = F.G * NTHR;
    for (int i = gt; i < DEPTH * 16 * DM; i += NGT) { const int l = i / (16 * DM), j = (i / DM) & 15, k = i % DM;
        ((bf16*)(F.ws + WS_WGA))[i] = (bf16)f2bf(F.norm1_g[l * DM + k] * F.w_in[((size_t)l * DM + k) * NIN + 3072 + j]); }
    for (int i = gt; i < 4 * T; i += NGT) ((float*)(F.ws + WS_SSQ))[T + i] = 0.f;
    if (F.bid == F.G - 1) {
        LAS float* red = (LAS float*)F.lds;
        __syncthreads();
        if (F.wave < DEPTH) { const float* qg = F.qn_g + F.wave * 128; const float* kg = F.kn_g + F.wave * 128;
            float v = fmaxf(fabsf(qg[F.lane] * kg[F.lane]), fabsf(qg[F.lane + 64] * kg[F.lane + 64]));
#pragma unroll
            for (int o = 1; o < 64; o <<= 1) v = fmaxf(v, __shfl_xor(v, o));
            if (F.lane == 0) red[F.wave] = v; }
        if (F.wave == DEPTH) { const int h = F.lane & 7, kg4 = F.lane >> 3; float v = -INFINITY;
#pragma unroll
            for (int k = 0; k < 4; ++k) v = fmaxf(v, F.rel_bias[(4 * kg4 + k) * 8 + h]);
            v = fmaxf(v, __shfl_xor(v, 8)); v = fmaxf(v, __shfl_xor(v, 16)); v = fmaxf(v, __shfl_xor(v, 32));
            if (F.lane < 8) red[DEPTH + F.lane] = v; }
        __syncthreads();
        if (F.tid < DEPTH * 8) ((float*)(F.ws + WS_MB))[F.tid] = red[F.tid >> 3] * 11.313708498984761f * 1.02f + red[DEPTH + (F.tid & 7)];
    }
}

__device__ __forceinline__ void phase_norm(const Ctx& F, const float* x, bf16* xb, float* ssq) {
    const int gw = F.bid * NWAVES + F.wave, NGW = F.G * NWAVES, lane = F.lane;
    for (int m = gw; m < T; m += NGW) {
        const f32x4* xr = (const f32x4*)(x + (size_t)m * DM) + lane;
        f32x4 v[8]; float s = 0.f;
#pragma unroll
        for (int j = 0; j < 8; ++j) { v[j] = xr[64 * j]; s += (v[j].x * v[j].x + v[j].y * v[j].y) + (v[j].z * v[j].z + v[j].w * v[j].w); }
        s = wave_sum(s);
        v2u* o8 = (v2u*)(xb + (size_t)m * DM) + lane;
#pragma unroll
        for (int j = 0; j < 8; ++j) { v2u w; w.x = pk2(v[j].x, v[j].y); w.y = pk2(v[j].z, v[j].w); o8[64 * j] = w; }
        if (lane == 0) ssq[m] = s;
    }
}

typedef short bf16x8 __attribute__((ext_vector_type(8)));
constexpr int NCHUNK = NB * 4 * 32;
__device__ __forceinline__ void gla_prep_item(const Ctx& F, int item, const bf16* proj, const bf16* xb, const float* ssq, const bf16* wga, const float* w2, const float* gb, bf16* QT, bf16* KD, bf16* VT, bf16* PT, float* DEC) {
    const int b = item >> 6, n = (item >> 1) & 31, hp = item & 1, tid = F.tid, col = tid & 127, rg = tid >> 7, lane = F.lane, fr = lane & 15, fg = lane >> 4;
    const size_t m0 = (size_t)b * SEQ + n * 64;
    LAS float* GAl = (LAS float*)F.lds;
    LAS float* TOT = GAl + 1024;
    LAS bf16* Ql = (LAS bf16*)(F.lds + 6144);
    LAS bf16* Kl = (LAS bf16*)(F.lds + 23552);
    LAS bf16* Vl = (LAS bf16*)(F.lds + 40960);
    LAS float* GP = (LAS float*)(F.lds + 74752);
    v4u ql[2], kl[2], vl[4];
#define PREP_LOAD(h_) do { \
        _Pragma("unroll") for (int e = 0; e < 2; ++e) { const int idx = tid + 512 * e, row = idx >> 4, pc = idx & 15; \
            ql[e] = *(const v4u*)(proj + (m0 + row) * LDP + C_QA + (h_) * 128 + pc * 8); kl[e] = *(const v4u*)(proj + (m0 + row) * LDP + C_KA + (h_) * 128 + pc * 8); } \
        _Pragma("unroll") for (int e = 0; e < 4; ++e) { const int idx = tid + 512 * e, row = idx >> 5, pc = idx & 31; vl[e] = *(const v4u*)(proj + (m0 + row) * LDP + C_VA + (h_) * 256 + pc * 8); } } while (0)
    xcd_arrive(F.bar);
    float w2c[16]; float bias = gb[(2 * hp) * 128 + col];
#pragma unroll
    for (int j = 0; j < 16; ++j) w2c[j] = w2[j * 512 + (2 * hp) * 128 + col];
    {
        constexpr int XS = 520;
        LAS bf16* XB0 = (LAS bf16*)(F.lds + 8192); LAS bf16* XB1 = XB0 + 64 * XS;
        f32x4 gacc[4];
#pragma unroll
        for (int rt = 0; rt < 4; ++rt) gacc[rt] = (f32x4){0.f, 0.f, 0.f, 0.f};
        v4u xr[8], xq[8];
#define GA_LOAD(R_, sl_) do { _Pragma("unroll") for (int e = 0; e < 8; ++e) { const int idx = tid + 512 * e, row = idx >> 6, pc = idx & 63; R_[e] = *(const v4u*)(xb + (m0 + row) * DM + 512 * (sl_) + 8 * pc); } } while (0)
#define GA_STORE(R_, buf_) do { _Pragma("unroll") for (int e = 0; e < 8; ++e) { const int idx = tid + 512 * e, row = idx >> 6, pc = idx & 63; *(LAS v4u*)((buf_) + row * XS + 8 * pc) = R_[e]; } } while (0)
#define GA_COMP(buf_, sl_) do { _Pragma("unroll") for (int ks = 0; ks < 2; ++ks) { const int kl_ = 64 * F.wave + 32 * ks + 8 * fg; const bf16x8 B = *(const bf16x8*)(wga + fr * DM + 512 * (sl_) + kl_); \
            _Pragma("unroll") for (int rt = 0; rt < 4; ++rt) { const bf16x8 A = *(const LAS bf16x8*)((buf_) + (16 * rt + fr) * XS + kl_); gacc[rt] = __builtin_amdgcn_mfma_f32_16x16x32_bf16(A, B, gacc[rt], 0, 0, 0); } } } while (0)
        GA_LOAD(xr, 0); GA_LOAD(xq, 1); GA_STORE(xr, XB0); GA_LOAD(xr, 2); LDS_BARRIER();
        GA_COMP(XB0, 0); GA_STORE(xq, XB1); GA_LOAD(xq, 3); LDS_BARRIER();
        GA_COMP(XB1, 1); LDS_BARRIER();
        GA_STORE(xr, XB0); GA_STORE(xq, XB1);
        xcd_wait(F.bar);
        PREP_LOAD(2 * hp);
        GA_COMP(XB0, 2); GA_COMP(XB1, 3); LDS_BARRIER();
#undef GA_LOAD
#undef GA_STORE
#undef GA_COMP
#pragma unroll
        for (int rt = 0; rt < 4; ++rt)
#pragma unroll
            for (int e = 0; e < 4; ++e) GP[(F.wave * 64 + 16 * rt + 4 * fg + e) * 16 + fr] = gacc[rt][e];
        __syncthreads();
#pragma unroll
        for (int e = 0; e < 2; ++e) { const int idx = tid + 512 * e; float sum = 0.f;
#pragma unroll
            for (int w = 0; w < 8; ++w) sum += GP[w * 1024 + idx];
            GAl[idx] = sum * (1.0f / sqrtf(ssq[m0 + (idx >> 4)] * (1.0f / DM) + RMS_EPS)); }
    }
#pragma unroll 1
    for (int hh = 0; hh < 2; ++hh) {
    const int h = 2 * hp + hh, ch = (b * 4 + h) * 32 + n;
#pragma unroll
    for (int e = 0; e < 2; ++e) { const int idx = tid + 512 * e, row = idx >> 4, pc = idx & 15; *(LAS v4u*)(Ql + row * 136 + pc * 8) = ql[e]; *(LAS v4u*)(Kl + row * 136 + pc * 8) = kl[e]; }
#pragma unroll
    for (int e = 0; e < 4; ++e) { const int idx = tid + 512 * e, row = idx >> 5, pc = idx & 31; *(LAS v4u*)(Vl + row * 264 + pc * 8) = vl[e]; }
    if (hh == 0) PREP_LOAD(2 * hp + 1);
    __syncthreads();
    float pre[16]; float run = 0.f;
#pragma unroll
    for (int i = 0; i < 16; ++i) { const LAS f32x4* gr = (const LAS f32x4*)(GAl + (16 * rg + i) * 16); float gp = bias;
#pragma unroll
        for (int q = 0; q < 4; ++q) { const f32x4 gv = gr[q]; gp += gv.x * w2c[4 * q] + gv.y * w2c[4 * q + 1] + gv.z * w2c[4 * q + 2] + gv.w * w2c[4 * q + 3]; }
        run += (fminf(gp, 0.f) - __logf(1.0f + __expf(-fabsf(gp)))) * (1.0f / 16.0f); pre[i] = run; }
    TOT[rg * 128 + col] = run;
    if (hh == 0) { bias = gb[(2 * hp + 1) * 128 + col];
#pragma unroll
        for (int j = 0; j < 16; ++j) w2c[j] = w2[j * 512 + (2 * hp + 1) * 128 + col]; }
    LDS_BARRIER();
    float off = 0.f, blast = 0.f;
#pragma unroll
    for (int r4 = 0; r4 < 4; ++r4) { const float t = TOT[r4 * 128 + col]; if (r4 < rg) off += t; blast += t; }
    unsigned kdp[8];
#pragma unroll
    for (int i = 0; i < 16; i += 2) { float kd2[2];
#pragma unroll
        for (int u = 0; u < 2; ++u) { const int row = 16 * rg + i + u; const float bb = off + pre[i + u];
            const float qv = bf2f(Ql[row * 136 + col]), kv = bf2f(Kl[row * 136 + col]);
            Ql[row * 136 + col] = (bf16)f2bf(qv * 0.08838834764831845f * __expf(bb)); Kl[row * 136 + col] = (bf16)f2bf(kv * __expf(-bb)); kd2[u] = kv * __expf(blast - bb); }
        kdp[i >> 1] = pk2(kd2[0], kd2[1]); }
    { v4u* kdo = (v4u*)(KD + ((size_t)ch * 128 + col) * 64 + 16 * rg); kdo[0] = (v4u){kdp[0], kdp[1], kdp[2], kdp[3]}; kdo[1] = (v4u){kdp[4], kdp[5], kdp[6], kdp[7]}; }
    if (rg == 0) DEC[ch * 128 + col] = __expf(blast);
#pragma unroll
    for (int e = 0; e < 4; ++e) { const int idx = tid + 512 * e, dv = idx >> 3, oct = idx & 7; const LAS bf16* vp = Vl + (8 * oct) * 264 + dv;
        v4u o; o.x = (unsigned)vp[0] | ((unsigned)vp[264] << 16); o.y = (unsigned)vp[2 * 264] | ((unsigned)vp[3 * 264] << 16);
        o.z = (unsigned)vp[4 * 264] | ((unsigned)vp[5 * 264] << 16); o.w = (unsigned)vp[6 * 264] | ((unsigned)vp[7 * 264] << 16);
        *(v4u*)(VT + ((size_t)ch * 256 + dv) * 64 + 8 * oct) = o; }
    __syncthreads();
#pragma unroll
    for (int e = 0; e < 2; ++e) { const int idx = tid + 512 * e, row = idx >> 4, pc = idx & 15; *(v4u*)(QT + ((size_t)ch * 64 + row) * 128 + pc * 8) = *(const LAS v4u*)(Ql + row * 136 + pc * 8); }
    {   const int qt = F.wave >> 1;
#pragma unroll
        for (int jj = 0; jj < 2; ++jj) { const int jt = 2 * (F.wave & 1) + jj; f32x4 acc = {0.f, 0.f, 0.f, 0.f};
            if (jt <= qt) {
#pragma unroll
                for (int ks = 0; ks < 4; ++ks) { const bf16x8 A = *(const LAS bf16x8*)(Kl + (16 * jt + fr) * 136 + 32 * ks + 8 * fg), B = *(const LAS bf16x8*)(Ql + (16 * qt + fr) * 136 + 32 * ks + 8 * fg);
                    acc = __builtin_amdgcn_mfma_f32_16x16x32_bf16(A, B, acc, 0, 0, 0); } }
            const int iq = 16 * qt + fr, j0 = 16 * jt + 4 * fg;
            v2u w; w.x = pk2(j0 <= iq ? acc[0] : 0.f, j0 + 1 <= iq ? acc[1] : 0.f); w.y = pk2(j0 + 2 <= iq ? acc[2] : 0.f, j0 + 3 <= iq ? acc[3] : 0.f);
            *(v2u*)(PT + ((size_t)ch * 64 + iq) * 64 + j0) = w; } }
    __syncthreads();
    }
#undef PREP_LOAD
}
__device__ __forceinline__ void st16_wt(void* p, v4u v) { asm volatile("global_store_dwordx4 %0, %1, off sc1\n\ts_nop 2" :: "v"(p), "v"(v) : "memory"); }
constexpr int SC_ROW = 72, SC_KD_B = 128 * SC_ROW * 2, SC_VT_B = 128 * SC_ROW * 2, SC_SLOT = SC_KD_B + SC_VT_B + 512;
struct ScanRegs { v4u kd[2], vt[2], dc; };
__device__ __forceinline__ void gla_scan_block(const Ctx& F, int task, const bf16* KD, const bf16* VT, const float* DEC, bf16* SN) {
    const int bh = task >> 1, dvh = task & 1, tid = F.tid, lane = F.lane, fr = lane & 15, fg = lane >> 4, kh = F.wave >> 2, dq = F.wave & 3;
    f32x4 S[4][2];
#pragma unroll
    for (int kt = 0; kt < 4; ++kt)
#pragma unroll
        for (int dt = 0; dt < 2; ++dt) S[kt][dt] = (f32x4){0.f, 0.f, 0.f, 0.f};
#define SC_LOAD(R_, ch_) do { const int c_ = (ch_); \
        _Pragma("unroll") for (int e = 0; e < 2; ++e) R_.kd[e] = *(const v4u*)(KD + (size_t)c_ * 128 * 64 + (size_t)(tid + 512 * e) * 8); \
        _Pragma("unroll") for (int e = 0; e < 2; ++e) R_.vt[e] = *(const v4u*)(VT + ((size_t)c_ * 256 + 128 * dvh) * 64 + (size_t)(tid + 512 * e) * 8); \
        if (tid < 32) R_.dc = *(const v4u*)(DEC + (size_t)c_ * 128 + tid * 4); } while (0)
#define SC_STORE(R_, slot_) do { LAS unsigned char* sl_ = F.lds + (slot_) * SC_SLOT; \
        _Pragma("unroll") for (int e = 0; e < 2; ++e) { const int idx = tid + 512 * e; *(LAS v4u*)(sl_ + ((idx >> 3) * SC_ROW + (idx & 7) * 8) * 2) = R_.kd[e]; } \
        _Pragma("unroll") for (int e = 0; e < 2; ++e) { const int idx = tid + 512 * e; *(LAS v4u*)(sl_ + SC_KD_B + ((idx >> 3) * SC_ROW + (idx & 7) * 8) * 2) = R_.vt[e]; } \
        if (tid < 32) *(LAS v4u*)(sl_ + SC_KD_B + SC_VT_B + tid * 16) = R_.dc; } while (0)
#define SC_STEP(n_, RS_, RL_) do { const int ch = bh * 32 + (n_); \
          \
        _Pragma("unroll") for (int dt = 0; dt < 2; ++dt) _Pragma("unroll") for (int j = 0; j < 2; ++j) { v4u wv; wv.x = pk2(S[2 * j][dt][0], S[2 * j][dt][1]); wv.y = pk2(S[2 * j][dt][2], S[2 * j][dt][3]); \
            wv.z = pk2(S[2 * j + 1][dt][0], S[2 * j + 1][dt][1]); wv.w = pk2(S[2 * j + 1][dt][2], S[2 * j + 1][dt][3]); \
            st16_wt(SN + (((size_t)ch * 4 + 2 * kh + j) * 256 + 128 * dvh + 32 * dq + 16 * dt + fr) * 32 + 8 * fg, wv); } \
        if ((n_) < 31) { \
            const LAS unsigned char* sl = F.lds + ((n_) & 1) * SC_SLOT; \
            bf16x8 Bf[2][2]; \
            _Pragma("unroll") for (int dt = 0; dt < 2; ++dt) _Pragma("unroll") for (int ks = 0; ks < 2; ++ks) Bf[dt][ks] = *(const LAS bf16x8*)(sl + SC_KD_B + ((32 * dq + 16 * dt + fr) * SC_ROW + 32 * ks + 8 * fg) * 2); \
            _Pragma("unroll") for (int kt = 0; kt < 4; ++kt) {   \
                const f32x4 dd = *(const LAS f32x4*)(sl + SC_KD_B + SC_VT_B + (64 * kh + 32 * (kt >> 1) + 8 * fg + 4 * (kt & 1)) * 4); \
                const int kr = 64 * kh + 32 * (kt >> 1) + 8 * (fr >> 2) + 4 * (kt & 1) + (fr & 3); \
                const bf16x8 A0 = *(const LAS bf16x8*)(sl + (kr * SC_ROW + 8 * fg) * 2), A1 = *(const LAS bf16x8*)(sl + (kr * SC_ROW + 32 + 8 * fg) * 2); \
                _Pragma("unroll") for (int dt = 0; dt < 2; ++dt) { f32x4 sv = S[kt][dt] * dd; sv = __builtin_amdgcn_mfma_f32_16x16x32_bf16(A0, Bf[dt][0], sv, 0, 0, 0); \
                    S[kt][dt] = __builtin_amdgcn_mfma_f32_16x16x32_bf16(A1, Bf[dt][1], sv, 0, 0, 0); } } \
              \
            SC_STORE(RS_, ((n_) + 1) & 1); \
            SC_LOAD(RS_, bh * 32 + ((n_) + 3 < 31 ? (n_) + 3 : 30)); \
            LDS_BARRIER(); } } while (0)
    ScanRegs RA, RB;
    SC_LOAD(RA, bh * 32); SC_STORE(RA, 0);
    SC_LOAD(RA, bh * 32 + 1); SC_LOAD(RB, bh * 32 + 2);
    LDS_BARRIER();
#pragma unroll 1
    for (int n = 0; n < 32; n += 2) { SC_STEP(n, RA, RB); SC_STEP(n + 1, RB, RA); }
#undef SC_LOAD
#undef SC_STORE
#undef SC_STEP
    __syncthreads();
}
template <bool SPLIT> __device__ __forceinline__ void gla_out_chunk(const Ctx& F, int ch, const bf16* proj, const bf16* QT, const bf16* VT, const bf16* PT, const bf16* SN, const float* gon, bf16* mix) {
    const int bh = ch >> 5, n = ch & 31, b = bh >> 2, h = bh & 3, tid = F.tid, lane = F.lane, fr = lane & 15, fg = lane >> 4, qt = F.wave >> 1, dvh = F.wave & 1, iq = 16 * qt + fr;
    const size_t m = (size_t)b * SEQ + n * 64 + iq;
    LAS unsigned char* SNl = F.lds;
    LAS bf16* VTl = (LAS bf16*)(F.lds + 69632);
    LAS bf16* QTl = (LAS bf16*)(F.lds + 106496);
    LAS bf16* PTl = (LAS bf16*)(F.lds + 123904);
    LAS float* red = (LAS float*)(F.lds + 133120);
    v4u sn[8];
    {   v4u vt[4], q2[2], p1;
        if (!SPLIT) {
#pragma unroll
            for (int e = 0; e < 8; ++e) { const int idx = tid + 512 * e; sn[e] = *(const v4u*)(SN + (size_t)ch * 256 * 128 + (size_t)idx * 8); } }
#pragma unroll
        for (int e = 0; e < 4; ++e) { const int idx = tid + 512 * e; vt[e] = *(const v4u*)(VT + (size_t)ch * 256 * 64 + (size_t)idx * 8); }
#pragma unroll
        for (int e = 0; e < 2; ++e) { const int idx = tid + 512 * e; q2[e] = *(const v4u*)(QT + (size_t)ch * 64 * 128 + (size_t)idx * 8); }
        p1 = *(const v4u*)(PT + (size_t)ch * 64 * 64 + (size_t)tid * 8);
        if (!SPLIT) {
#pragma unroll
            for (int e = 0; e < 8; ++e) { const int idx = tid + 512 * e, kb = idx >> 10, dv = (idx >> 2) & 255; *(LAS v4u*)(SNl + kb * 17408 + dv * 64 + (dv >> 2) * 16 + (idx & 3) * 16) = sn[e]; } }
#pragma unroll
        for (int e = 0; e < 4; ++e) { const int idx = tid + 512 * e; *(LAS v4u*)(VTl + (idx >> 3) * 72 + (idx & 7) * 8) = vt[e]; }
#pragma unroll
        for (int e = 0; e < 2; ++e) { const int idx = tid + 512 * e; *(LAS v4u*)(QTl + (idx >> 4) * 136 + (idx & 15) * 8) = q2[e]; }
        *(LAS v4u*)(PTl + (tid >> 3) * 72 + (tid & 7) * 8) = p1;
    }
    v2u rw[8];
#pragma unroll
    for (int t = 0; t < 8; ++t) rw[t] = *(const v2u*)(proj + m * LDP + C_RA + h * 256 + 128 * dvh + 16 * t + 4 * fg);
    if (SPLIT) { xcd_wait(F.bar);
#pragma unroll
        for (int e = 0; e < 8; ++e) { const int idx = tid + 512 * e; sn[e] = *(const v4u*)(SN + (size_t)ch * 256 * 128 + (size_t)idx * 8); } }
    else __syncthreads();
    f32x4 acc[8];
#pragma unroll
    for (int t = 0; t < 8; ++t) acc[t] = (f32x4){0.f, 0.f, 0.f, 0.f};
#pragma unroll
    for (int ks = 0; ks < 2; ++ks) if (32 * ks <= 16 * qt + 15) { const bf16x8 Bp = *(const LAS bf16x8*)(PTl + iq * 72 + 32 * ks + 8 * fg);
#pragma unroll
        for (int t = 0; t < 8; ++t) { const bf16x8 A = *(const LAS bf16x8*)(VTl + (128 * dvh + 16 * t + fr) * 72 + 32 * ks + 8 * fg); acc[t] = __builtin_amdgcn_mfma_f32_16x16x32_bf16(A, Bp, acc[t], 0, 0, 0); } }
    if (SPLIT) {
#pragma unroll
        for (int e = 0; e < 8; ++e) { const int idx = tid + 512 * e, kb = idx >> 10, dv = (idx >> 2) & 255; *(LAS v4u*)(SNl + kb * 17408 + dv * 64 + (dv >> 2) * 16 + (idx & 3) * 16) = sn[e]; }
        __syncthreads(); }
    if (n > 0) {
#pragma unroll
        for (int ks = 0; ks < 4; ++ks) { const bf16x8 Bq = *(const LAS bf16x8*)(QTl + iq * 136 + 32 * ks + 8 * fg);
#pragma unroll
            for (int t = 0; t < 8; ++t) { const int dv = 128 * dvh + 16 * t + fr; const bf16x8 A = *(const LAS bf16x8*)(SNl + ks * 17408 + dv * 64 + (dv >> 2) * 16 + fg * 16); acc[t] = __builtin_amdgcn_mfma_f32_16x16x32_bf16(A, Bq, acc[t], 0, 0, 0); } } }
    float ss = 0.f;
#pragma unroll
    for (int t = 0; t < 8; ++t) ss += (acc[t][0] * acc[t][0] + acc[t][1] * acc[t][1]) + (acc[t][2] * acc[t][2] + acc[t][3] * acc[t][3]);
    ss += __shfl_xor(ss, 16); ss += __shfl_xor(ss, 32);
    if (fg == 0) red[F.wave * 16 + fr] = ss;
    __syncthreads();
    const float tot = red[(2 * qt) * 16 + fr] + red[(2 * qt + 1) * 16 + fr];
    const float rstd = 1.0f / sqrtf(tot * (1.0f / 256.0f) + RMS_EPS);
#pragma unroll
    for (int t = 0; t < 8; ++t) { const int dv0 = 128 * dvh + 16 * t + 4 * fg; const f32x4 g4 = *(const f32x4*)(gon + dv0);
        const float r0 = bflo(rw[t].x), r1 = bfhi(rw[t].x), r2 = bflo(rw[t].y), r3 = bfhi(rw[t].y);
        const float y0 = acc[t][0] * rstd * g4.x * (r0 / (1.0f + __expf(-r0))), y1 = acc[t][1] * rstd * g4.y * (r1 / (1.0f + __expf(-r1)));
        const float y2 = acc[t][2] * rstd * g4.z * (r2 / (1.0f + __expf(-r2))), y3 = acc[t][3] * rstd * g4.w * (r3 / (1.0f + __expf(-r3)));
        v2u w; w.x = pk2(y0, y1); w.y = pk2(y2, y3); *(v2u*)(mix + m * DM + h * 256 + dv0) = w; }
    __syncthreads();
}

__device__ __forceinline__ void gla_out_pair(const Ctx& F, int chA, int chB, const bf16* proj, const bf16* QT, const bf16* VT, const bf16* PT, const bf16* SN, const float* gon, bf16* mix) {
    const int tid = F.tid, lane = F.lane, fr = lane & 15, fg = lane >> 4, qt = F.wave >> 1, dvh = F.wave & 1, iq = 16 * qt + fr;
    LAS unsigned char* SNl = F.lds; LAS bf16* VTl = (LAS bf16*)(F.lds + 69632); LAS bf16* QTl = (LAS bf16*)(F.lds + 106496); LAS bf16* PTl = (LAS bf16*)(F.lds + 123904); LAS float* red = (LAS float*)(F.lds + 133120);
    const int hA = (chA >> 5) & 3, nA = chA & 31, hB = (chB >> 5) & 3, nB = chB & 31;
    const size_t mA = (size_t)(chA >> 7) * SEQ + nA * 64 + iq, mB = (size_t)(chB >> 7) * SEQ + nB * 64 + iq;
    v4u sn[8], vt[4], q2[2], p1; v2u rw[8];
#define GO_LOAD_VQP(ch_) do { _Pragma("unroll") for (int e = 0; e < 4; ++e) { const int idx = tid + 512 * e; vt[e] = *(const v4u*)(VT + (size_t)(ch_) * 256 * 64 + (size_t)idx * 8); } \
        _Pragma("unroll") for (int e = 0; e < 2; ++e) { const int idx = tid + 512 * e; q2[e] = *(const v4u*)(QT + (size_t)(ch_) * 64 * 128 + (size_t)idx * 8); } \
        p1 = *(const v4u*)(PT + (size_t)(ch_) * 64 * 64 + (size_t)tid * 8); } while (0)
#define GO_STORE_VQP() do { _Pragma("unroll") for (int e = 0; e < 4; ++e) { const int idx = tid + 512 * e; *(LAS v4u*)(VTl + (idx >> 3) * 72 + (idx & 7) * 8) = vt[e]; } \
        _Pragma("unroll") for (int e = 0; e < 2; ++e) { const int idx = tid + 512 * e; *(LAS v4u*)(QTl + (idx >> 4) * 136 + (idx & 15) * 8) = q2[e]; } \
        *(LAS v4u*)(PTl + (tid >> 3) * 72 + (tid & 7) * 8) = p1; } while (0)
#define GO_LOAD_SN(ch_, e0_, e1_) do { _Pragma("unroll") for (int e = (e0_); e < (e1_); ++e) { const int idx = tid + 512 * e; sn[e] = *(const v4u*)(SN + (size_t)(ch_) * 256 * 128 + (size_t)idx * 8); } } while (0)
#define GO_STORE_SN() do { _Pragma("unroll") for (int e = 0; e < 8; ++e) { const int idx = tid + 512 * e, kb = idx >> 10, dv = (idx >> 2) & 255; *(LAS v4u*)(SNl + kb * 17408 + dv * 64 + (dv >> 2) * 16 + (idx & 3) * 16) = sn[e]; } } while (0)
#define GO_LOAD_RW(m_, h_) do { _Pragma("unroll") for (int t = 0; t < 8; ++t) rw[t] = *(const v2u*)(proj + (m_) * LDP + C_RA + (h_) * 256 + 128 * dvh + 16 * t + 4 * fg); } while (0)
#define GO_INTRA() do { _Pragma("unroll") for (int ks = 0; ks < 2; ++ks) if (32 * ks <= 16 * qt + 15) { const bf16x8 Bp = *(const LAS bf16x8*)(PTl + iq * 72 + 32 * ks + 8 * fg); \
        _Pragma("unroll") for (int t = 0; t < 8; ++t) { const bf16x8 A = *(const LAS bf16x8*)(VTl + (128 * dvh + 16 * t + fr) * 72 + 32 * ks + 8 * fg); acc[t] = __builtin_amdgcn_mfma_f32_16x16x32_bf16(A, Bp, acc[t], 0, 0, 0); } } } while (0)
#define GO_INTER_KS(ks_) do { const bf16x8 Bq = *(const LAS bf16x8*)(QTl + iq * 136 + 32 * (ks_) + 8 * fg); \
        _Pragma("unroll") for (int t = 0; t < 8; ++t) { const int dv = 128 * dvh + 16 * t + fr; const bf16x8 A = *(const LAS bf16x8*)(SNl + (ks_) * 17408 + dv * 64 + (dv >> 2) * 16 + fg * 16); acc[t] = __builtin_amdgcn_mfma_f32_16x16x32_bf16(A, Bq, acc[t], 0, 0, 0); } } while (0)
#define GO_NORM_SUM() do { float ss = 0.f; _Pragma("unroll") for (int t = 0; t < 8; ++t) ss += (acc[t][0] * acc[t][0] + acc[t][1] * acc[t][1]) + (acc[t][2] * acc[t][2] + acc[t][3] * acc[t][3]); \
        ss += __shfl_xor(ss, 16); ss += __shfl_xor(ss, 32); if (fg == 0) red[F.wave * 16 + fr] = ss; } while (0)
#define GO_EPILOGUE(m_, h_) do { const float tot = red[(2 * qt) * 16 + fr] + red[(2 * qt + 1) * 16 + fr]; const float rstd = 1.0f / sqrtf(tot * (1.0f / 256.0f) + RMS_EPS); \
        _Pragma("unroll") for (int t = 0; t < 8; ++t) { const int dv0 = 128 * dvh + 16 * t + 4 * fg; const f32x4 g4 = *(const f32x4*)(gon + dv0); \
            const float r0 = bflo(rw[t].x), r1 = bfhi(rw[t].x), r2 = bflo(rw[t].y), r3 = bfhi(rw[t].y); \
            const float y0 = acc[t][0] * rstd * g4.x * (r0 / (1.0f + __expf(-r0))), y1 = acc[t][1] * rstd * g4.y * (r1 / (1.0f + __expf(-r1))); \
            const float y2 = acc[t][2] * rstd * g4.z * (r2 / (1.0f + __expf(-r2))), y3 = acc[t][3] * rstd * g4.w * (r3 / (1.0f + __expf(-r3))); \
            v2u w; w.x = pk2(y0, y1); w.y = pk2(y2, y3); *(v2u*)(mix + (m_) * DM + (h_) * 256 + dv0) = w; } } while (0)
    f32x4 acc[8];
    GO_LOAD_VQP(chA); GO_STORE_VQP(); GO_LOAD_RW(mA, hA);
    xcd_wait(F.bar);
    GO_LOAD_SN(chA, 0, 8);
#pragma unroll
    for (int t = 0; t < 8; ++t) acc[t] = (f32x4){0.f, 0.f, 0.f, 0.f};
    GO_INTRA();
    GO_STORE_SN();
    GO_LOAD_VQP(chB);
    __syncthreads();
#pragma unroll
    for (int ks = 0; ks < 4; ++ks) { GO_LOAD_SN(chB, 2 * ks, 2 * ks + 2); __builtin_amdgcn_sched_barrier(0); if (nA > 0) GO_INTER_KS(ks); }
    GO_NORM_SUM();
    __syncthreads();
    GO_EPILOGUE(mA, hA);
    GO_LOAD_RW(mB, hB);
    __syncthreads();
    GO_STORE_SN(); GO_STORE_VQP();
    __syncthreads();
#pragma unroll
    for (int t = 0; t < 8; ++t) acc[t] = (f32x4){0.f, 0.f, 0.f, 0.f};
    GO_INTRA();
    if (nB > 0) {
#pragma unroll
        for (int ks = 0; ks < 4; ++ks) GO_INTER_KS(ks); }
    GO_NORM_SUM();
    __syncthreads();
    GO_EPILOGUE(mB, hB);
    __syncthreads();
#undef GO_LOAD_VQP
#undef GO_STORE_VQP
#undef GO_LOAD_SN
#undef GO_STORE_SN
#undef GO_LOAD_RW
#undef GO_INTRA
#undef GO_INTER_KS
#undef GO_NORM_SUM
#undef GO_EPILOGUE
}

typedef short s16x4 __attribute__((ext_vector_type(4)));
constexpr int AT_KROW = 136, AT_VROW = 144;
constexpr int AT_V_OFF = 256 * AT_KROW * 2, AT_TB_OFF = AT_V_OFF + 256 * AT_VROW * 2;
constexpr float LOG2E = 1.4426950408889634f;
struct AttnUnit { int b, h, br, cls, pb; };
__device__ const unsigned char kAttnPlan[28][8] = {
 {1,50,99,148,35,90,160,255},
 {2,51,100,149,36,91,164,255},
 {3,52,101,150,37,92,168,255},
 {4,53,102,151,38,93,172,255},
 {5,54,103,152,39,94,176,255},
 {6,55,104,153,40,95,177,255},
 {7,56,105,154,41,96,178,255},
 {8,57,106,155,42,112,179,255},
 {9,58,107,156,43,116,180,255},
 {10,59,108,157,44,120,181,255},
 {11,60,109,158,45,124,182,255},
 {12,61,110,159,46,128,183,255},
 {13,62,111,161,47,129,184,255},
 {14,63,113,162,48,130,185,255},
 {15,65,114,163,64,131,186,255},
 {17,66,115,165,68,132,187,255},
 {18,67,117,166,72,133,188,255},
 {19,69,118,167,76,134,189,255},
 {21,70,119,169,80,135,190,255},
 {22,71,121,170,81,136,191,255},
 {23,73,122,171,82,137,255,255},
 {25,74,123,173,83,138,255,255},
 {26,75,125,174,84,139,255,255},
 {27,77,126,175,85,140,255,255},
 {29,78,127,0,28,86,141,255},
 {30,79,145,16,32,87,142,255},
 {31,97,146,20,33,88,143,255},
 {49,98,147,24,34,89,144,255}};
__device__ __forceinline__ AttnUnit attn_unit_of(int bid, int it) {
    const int q = kAttnPlan[(bid - 32) >> 3][it], bh = 8 * (q / 48) + (bid & 7), rem = q % 48, br = rem >> 4, uu = rem & 15;
    AttnUnit u; u.b = bh >> 3; u.h = bh & 7; u.br = br; u.cls = br == 0 ? 0 : (br == 1 ? uu >> 2 : uu); u.pb = br == 0 ? uu : (br == 1 ? (uu & 3) : 0); return u;
}
__device__ __forceinline__ void attn_phase(const Ctx& F, const bf16* proj, const float* rel_bias, const float* mb  , bf16* OP0, bf16* OP1, bf16* OP2, float* LP) {
    const int tid = F.tid, lane = F.lane, fr = lane & 15, fg = lane >> 4, w = F.wave;
    LAS bf16* Kl = (LAS bf16*)F.lds; LAS bf16* Vl = (LAS bf16*)(F.lds + AT_V_OFF); LAS float* tb = (LAS float*)(F.lds + AT_TB_OFF);
    v4u kreg[8], vreg[8]; bf16x8 Qn[4];
#define AT_LOAD(U_) do { const int sh_ = 2 * (U_).br; const bf16* pb_ = proj + ((size_t)(U_).h * T + (size_t)(U_).b * SEQ) * 128;     \
        _Pragma("unroll") for (int e = 0; e < 8; ++e) { if (e < 4 && (U_).pb == 0) continue;     \
            const int idx = tid + 512 * e, row = idx >> 4, pc = idx & 15; const int pos = 128 * ((U_).pb - 1) + row; \
            const bf16* rp = pb_ + (size_t)((pos << sh_) + (U_).cls) * 128 + 8 * pc; kreg[e] = *(const v4u*)(rp + (size_t)8 * T * 128); vreg[e] = *(const v4u*)(rp + (size_t)16 * T * 128); } \
        { const int tq_ = ((128 * (U_).pb + 16 * w + fr) << sh_) + (U_).cls; \
          _Pragma("unroll") for (int ks = 0; ks < 4; ++ks) Qn[ks] = *(const bf16x8*)(pb_ + (size_t)tq_ * 128 + 32 * ks + 8 * fg); } } while (0)
#define AT_LOAD_PART(U_, p_) do { const int sh_ = 2 * (U_).br; const bf16* pb_ = proj + ((size_t)(U_).h * T + (size_t)(U_).b * SEQ) * 128; \
        if ((p_) < 4) { _Pragma("unroll") for (int e = 2 * (p_); e < 2 * (p_) + 2; ++e) { if (e < 4 && (U_).pb == 0) continue; \
            const int idx = tid + 512 * e, row = idx >> 4, pc = idx & 15; const int pos = 128 * ((U_).pb - 1) + row; \
            const bf16* rp = pb_ + (size_t)((pos << sh_) + (U_).cls) * 128 + 8 * pc; kreg[e] = *(const v4u*)(rp + (size_t)8 * T * 128); vreg[e] = *(const v4u*)(rp + (size_t)16 * T * 128); } } \
        else { const int tq_ = ((128 * (U_).pb + 16 * w + fr) << sh_) + (U_).cls; \
          _Pragma("unroll") for (int ks = 0; ks < 4; ++ks) Qn[ks] = *(const bf16x8*)(pb_ + (size_t)tq_ * 128 + 32 * ks + 8 * fg); } } while (0)
#define AT_STORE(U_) do { \
        _Pragma("unroll") for (int e = 0; e < 8; ++e) { if (e < 4 && (U_).pb == 0) continue; \
            const int idx = tid + 512 * e, row = idx >> 4, pc = idx & 15; *(LAS v4u*)(Kl + row * AT_KROW + 8 * pc) = kreg[e]; *(LAS v4u*)(Vl + row * AT_VROW + 8 * pc) = vreg[e]; } \
        } while (0)
    int nun = 0; for (int i = 0; i < 8; ++i) nun += kAttnPlan[(F.bid - 32) >> 3][i] != 255 ? 1 : 0;
    AttnUnit U = attn_unit_of(F.bid, 0);
    AT_LOAD(U);
    if (tid < 396) { const int hh = F.bid & 7, br_ = tid / 132, e_ = tid % 132;
        const float M = mb[hh]; float v = -INFINITY;
        if (e_ >= 1 && e_ <= 129) v = (rel_bias[kBucket[br_][e_ - 1] * 8 + hh] - M) * LOG2E;
        tb[tid] = v; }
    AT_STORE(U);
    __syncthreads();
    const unsigned tr_off = (unsigned)(((fr >> 2) + 4 * fg) * AT_VROW + 4 * (fr & 3)) * 2u;
#pragma unroll 1
    for (int it = 0; it < nun; ++it) {
        bf16x8 Qf[4];
#pragma unroll
        for (int ks = 0; ks < 4; ++ks) Qf[ks] = Qn[ks];
        const AttnUnit Un = attn_unit_of(F.bid, it + 1 < nun ? it + 1 : it);
        const bool more = it + 1 < nun;
        f32x4 O[8];
#pragma unroll
        for (int t = 0; t < 8; ++t) O[t] = (f32x4){0.f, 0.f, 0.f, 0.f};
        float lsum = 0.f;
        int a_lo = w >> 1; const int a_hi = (w >> 1) + 4; if (U.pb == 0 && a_lo < 4) a_lo = 4;
        const LAS float* tbu = tb + 132 * U.br;
        const int relc = 129 + 16 * w + fr - 4 * fg;
#pragma unroll
        for (int ai_ = 0; ai_ < 5; ++ai_) { if (more) AT_LOAD_PART(Un, ai_); __builtin_amdgcn_sched_barrier(0); const int a = (w >> 1) + ai_; if (a < a_lo) continue;
            f32x4 sa = {0.f, 0.f, 0.f, 0.f}, sb = {0.f, 0.f, 0.f, 0.f};
            const LAS bf16* kp = Kl + (32 * a + fr) * AT_KROW + 8 * fg;
#pragma unroll
            for (int ks = 0; ks < 4; ++ks) { const bf16x8 Ka = *(const LAS bf16x8*)(kp + 32 * ks), Kb = *(const LAS bf16x8*)(kp + 16 * AT_KROW + 32 * ks);
                sa = __builtin_amdgcn_mfma_f32_16x16x32_bf16(Ka, Qf[ks], sa, 0, 0, 0); sb = __builtin_amdgcn_mfma_f32_16x16x32_bf16(Kb, Qf[ks], sb, 0, 0, 0); }
            const int ia = relc - 32 * a; float pa_[4], pb_[4];
#pragma unroll
            for (int e = 0; e < 4; ++e) { int xa = ia - e, xb = ia - 16 - e; xa = xa < 0 ? 0 : (xa > 130 ? 130 : xa); xb = xb < 0 ? 0 : (xb > 130 ? 130 : xb);
                pa_[e] = __builtin_amdgcn_exp2f(sa[e] + tbu[xa]); pb_[e] = __builtin_amdgcn_exp2f(sb[e] + tbu[xb]); }
            lsum += ((pa_[0] + pa_[1]) + (pa_[2] + pa_[3])) + ((pb_[0] + pb_[1]) + (pb_[2] + pb_[3]));
            v4u pw; pw.x = pk2(pa_[0], pa_[1]); pw.y = pk2(pa_[2], pa_[3]); pw.z = pk2(pb_[0], pb_[1]); pw.w = pk2(pb_[2], pb_[3]);
            const bf16x8 Pf = __builtin_bit_cast(bf16x8, pw);
            LAS unsigned char* vb = (LAS unsigned char*)Vl + (32 * a) * (AT_VROW * 2) + tr_off;
#pragma unroll
            for (int t = 0; t < 8; ++t) {
                const s16x4 va = __builtin_bit_cast(s16x4, __builtin_amdgcn_ds_read_tr16_b64_v4i16((LAS s16x4*)(vb + 32 * t)));
                const s16x4 vb2 = __builtin_bit_cast(s16x4, __builtin_amdgcn_ds_read_tr16_b64_v4i16((LAS s16x4*)(vb + 16 * AT_VROW * 2 + 32 * t)));
                const bf16x8 Vf = {va[0], va[1], va[2], va[3], vb2[0], vb2[1], vb2[2], vb2[3]};
                O[t] = __builtin_amdgcn_mfma_f32_16x16x32_bf16(Vf, Pf, O[t], 0, 0, 0); }
        }
        lsum += __shfl_xor(lsum, 16); lsum += __shfl_xor(lsum, 32);
        {   const float inv = 1.0f / lsum; const int tq = ((128 * U.pb + 16 * w + fr) << (2 * U.br)) + U.cls; const size_t m = (size_t)U.b * SEQ + tq;
            bf16* op = (U.br == 0 ? OP0 : (U.br == 1 ? OP1 : OP2)) + m * 1024 + U.h * 128 + 4 * fg;
#pragma unroll
            for (int t = 0; t < 8; ++t) { v2u wv; wv.x = pk2(O[t][0] * inv, O[t][1] * inv); wv.y = pk2(O[t][2] * inv, O[t][3] * inv); *(v2u*)(op + 16 * t) = wv; }
            if (fg == 0) LP[((size_t)U.br * T + m) * 8 + U.h] = lsum; }
        LDS_BARRIER();
        if (it + 1 < nun) { AT_STORE(Un); LDS_BARRIER(); }
        U = Un;
    }
#undef AT_LOAD
#undef AT_LOAD_PART
#undef AT_STORE
}
__device__ __forceinline__ void attn_combine(const Ctx& F, const bf16* OP0, const bf16* OP1, const bf16* OP2, const float* LP, bf16* mix) {
    for (int i = F.bid * NTHR + F.tid; i < T * 128; i += F.G * NTHR) { const int m = i >> 7, pc = i & 127, h = pc >> 4;
        const float l0 = LP[(size_t)m * 8 + h], l1 = LP[((size_t)T + m) * 8 + h], l2 = LP[((size_t)2 * T + m) * 8 + h]; const float inv = 1.0f / (l0 + l1 + l2);
        const float w0 = l0 * inv, w1 = l1 * inv, w2 = l2 * inv;
        const v4u a = *(const v4u*)(OP0 + (size_t)m * 1024 + 8 * pc), b = *(const v4u*)(OP1 + (size_t)m * 1024 + 8 * pc), c = *(const v4u*)(OP2 + (size_t)m * 1024 + 8 * pc);
        v4u o;
        o.x = pk2(w0 * bflo(a.x) + w1 * bflo(b.x) + w2 * bflo(c.x), w0 * bfhi(a.x) + w1 * bfhi(b.x) + w2 * bfhi(c.x));
        o.y = pk2(w0 * bflo(a.y) + w1 * bflo(b.y) + w2 * bflo(c.y), w0 * bfhi(a.y) + w1 * bfhi(b.y) + w2 * bfhi(c.y));
        o.z = pk2(w0 * bflo(a.z) + w1 * bflo(b.z) + w2 * bflo(c.z), w0 * bfhi(a.z) + w1 * bfhi(b.z) + w2 * bfhi(c.z));
        o.w = pk2(w0 * bflo(a.w) + w1 * bflo(b.w) + w2 * bflo(c.w), w0 * bfhi(a.w) + w1 * bfhi(b.w) + w2 * bfhi(c.w));
        *(v4u*)(mix + (size_t)m * DM + 1024 + 8 * pc) = o; }
}

constexpr int NPHASE = 2 + 7 * DEPTH;
struct Args { const float* in[14]; float* out; unsigned char* ws; int ph_lo, ph_hi; };
#define PH_IN(k) (lo <= (k) && (k) < hi)
#define PH_END(k) do { if (PH_IN((k) + 1)) { if ((k) < 0) grid.sync(); else xcd_barrier(F.bar); } } while (0)
template <int L> __device__ __forceinline__ void layer_phases(const Ctx& F, const int lo, const int hi, cg::grid_group& grid) {
    constexpr int P0 = 2 + 7 * L;
    bf16* QT = (bf16*)(F.ws + WS_QT); bf16* KD = (bf16*)(F.ws + WS_KD); bf16* VT = (bf16*)(F.ws + WS_VT); bf16* PT = (bf16*)(F.ws + WS_PT); float* DEC = (float*)(F.ws + WS_DEC); bf16* SN = (bf16*)(F.ws + WS_SN);
    bf16* XB = (bf16*)(F.ws + WS_XB); bf16* PROJ = (bf16*)(F.ws + WS_PROJ); bf16* ATT = PROJ + (size_t)T * LDP;     bf16* HMID = (bf16*)(F.ws + WS_HMID); bf16* MIX = (bf16*)(F.ws + WS_MIX);
    float* SSQ = (float*)(F.ws + WS_SSQ);
    if (PH_IN(P0 + 0)) {
        pg8::Gemm g{XB, (const bf16*)(F.ws + WS_WIN + L * SZ_WIN), T, NPROJ, DM}; pg8::StaticOrder S; S.init(T, NPROJ, F.G, F.bid);
        pg8::EpiBf16<0> E{PROJ, LDP, SSQ + (2 * L) * T, C_QB / 256, C_KB / 256, C_VB / 256, F.qn_g + L * 128, F.kn_g + L * 128, 0.08838834764831845f * 1.4426950408889634f, (LAS float*)(F.lds + 131072), ATT, T};
        pg8::gemm_phase<pg8::EpiBf16<0>, pg8::StaticOrder, true, true>(F.lds, g, S, E); }
    if (PH_IN(P0 + 1)) {
        { const int it = (((F.bid >> 4) * 8 + (F.bid & 7)) << 1) | ((F.bid >> 3) & 1);
          gla_prep_item(F, it, PROJ, XB, SSQ + (2 * L) * T, (const bf16*)(F.ws + WS_WGA) + L * 16 * DM, F.gate_w2 + L * 16 * 512, F.gate_b + L * 512, QT, KD, VT, PT, DEC); }
        xcd_arrive(F.bar);
        bf16* OP0 = (bf16*)F.out; bf16* OP1 = OP0 + (size_t)T * 1024; bf16* OP2 = (bf16*)(F.ws + WS_OP2); float* LP = (float*)(F.ws + WS_LP);
        if (F.bid < 32) { xcd_wait(F.bar); gla_scan_block(F, F.bid, KD, VT, DEC, SN); }
        else { attn_phase(F, ATT, F.rel_bias, (const float*)(F.ws + WS_MB) + L * 8, OP0, OP1, OP2, LP); xcd_wait(F.bar); }

        xcd_arrive(F.bar);
        gla_out_pair(F, F.bid, F.bid + 256, PROJ, QT, VT, PT, SN, F.onorm_g + L * 256, MIX);
        attn_combine(F, (const bf16*)F.out, (const bf16*)F.out + (size_t)T * 1024, (const bf16*)(F.ws + WS_OP2), (const float*)(F.ws + WS_LP), MIX);
        PH_END(P0 + 3); }
    if (PH_IN(P0 + 4)) {
        pg8::Gemm g{MIX, (const bf16*)(F.ws + WS_WOUT + L * SZ_WOUT), T, DM, DM}; pg8::StaticOrder S; S.init(T, DM, F.G, F.bid);
        { pg8::EpiResB<false> E{nullptr, XB, XB, DM, SSQ + (2 * L + 1) * T}; pg8::gemm_phase<pg8::EpiResB<false>, pg8::StaticOrder, true, true>(F.lds, g, S, E); }
        PH_END(P0 + 4); }
    if (PH_IN(P0 + 5)) {
        pg8::Gemm g{XB, (const bf16*)(F.ws + WS_WGU + L * SZ_WGU), T, NGU, DM}; pg8::StaticOrder S; S.init(T, NGU, F.G, F.bid);
        pg8::EpiSwiglu E{HMID, FFN, SSQ + (2 * L + 1) * T};
        pg8::gemm_phase<pg8::EpiSwiglu, pg8::StaticOrder, true, true>(F.lds, g, S, E);
        PH_END(P0 + 5); }
    if (PH_IN(P0 + 6)) {
        pg8::Gemm g{HMID, (const bf16*)(F.ws + WS_WD + L * SZ_WD), T, DM, FFN}; pg8::StaticOrder S; S.init(T, DM, F.G, F.bid);
        if (L + 1 < DEPTH) { pg8::EpiResB<false> E{nullptr, XB, XB, DM, SSQ + (2 * L + 2) * T}; pg8::gemm_phase<pg8::EpiResB<false>, pg8::StaticOrder, true, true>(F.lds, g, S, E); }
        else { pg8::EpiResF E{XB, F.out, DM}; pg8::gemm_phase<pg8::EpiResF, pg8::StaticOrder, true, true>(F.lds, g, S, E); }
        PH_END(P0 + 6); }
}
__global__ void __launch_bounds__(NTHR, 2) fwd(Args a) {
    extern __shared__ __attribute__((aligned(16))) unsigned char lds_raw[];
#ifdef CODE_SHIFT_NOPS
    asm volatile(".rept " CODE_SHIFT_STR "\n\ts_nop 0\n\t.endr" ::: "memory");
#endif
    Ctx F;
    F.lds = (LAS unsigned char*)lds_raw; F.tid = threadIdx.x; F.lane = F.tid & 63; F.wave = __builtin_amdgcn_readfirstlane(F.tid >> 6); F.G = gridDim.x; F.bid = blockIdx.x;
    F.x = a.in[0]; F.norm1_g = a.in[1]; F.w_in = a.in[2]; F.gate_w2 = a.in[3]; F.gate_b = a.in[4]; F.onorm_g = a.in[5]; F.qn_g = a.in[6]; F.kn_g = a.in[7]; F.rel_bias = a.in[8];
    F.w_out = a.in[9]; F.norm2_g = a.in[10]; F.w_gate = a.in[11]; F.w_up = a.in[12]; F.w_down = a.in[13]; F.out = a.out; F.ws = a.ws;
    const int lo = a.ph_lo, hi = a.ph_hi;
    cg::grid_group grid = cg::this_grid();
    if (hi > NPHASE) grid.sync();
    { volatile LAS unsigned* st = (volatile LAS unsigned*)(F.lds + LDS_BYTES - 64); if (F.tid < 2) st[F.tid] = 0u; __syncthreads();
      F.bar = xcd_barrier_post((unsigned*)(F.ws + WS_CTL) + 4096, st); }
    if (PH_IN(0)) { phase_convert(F); }
    if (PH_IN(1)) { phase_norm(F, F.x, (bf16*)(F.ws + WS_XB), (float*)(F.ws + WS_SSQ)); PH_END(1); }
    layer_phases<0>(F, lo, hi, grid);
    layer_phases<1>(F, lo, hi, grid);
}

extern "C" void kernel_launch(void* const* d_in, const int* in_sizes, int n_in, void* d_out, int out_size, void* d_ws, size_t ws_size, hipStream_t stream) {
    static int grid = 0;
    if (grid == 0) {
        if (n_in != 14 || out_size != T * DM || ws_size < WS_END) { fprintf(stderr, "kernel_launch: unexpected shapes (n_in %d, out %d, ws %zu)\n", n_in, out_size, ws_size); grid = -1; return; }
        if (hipFuncSetAttribute((const void*)fwd, hipFuncAttributeMaxDynamicSharedMemorySize, LDS_BYTES) != hipSuccess) { fprintf(stderr, "kernel_launch: hipFuncSetAttribute failed\n"); grid = -1; return; }
        int dev = 0, cus = 0, per_cu = 0;
        (void)hipGetDevice(&dev); (void)hipDeviceGetAttribute(&cus, hipDeviceAttributeMultiprocessorCount, dev);
        (void)hipOccupancyMaxActiveBlocksPerMultiprocessor(&per_cu, (const void*)fwd, NTHR, LDS_BYTES);
        if (per_cu < 1 || cus < 1) { fprintf(stderr, "kernel_launch: occupancy query says %d blocks/CU on %d CUs\n", per_cu, cus); grid = -1; return; }
        if (cus < 256) { fprintf(stderr, "kernel_launch: built for a 256-CU device (found %d CUs)\n", cus); grid = -1; return; }
        grid = 256;
    }
    if (grid < 0) return;
    Args a{};
    for (int i = 0; i < 14; ++i) a.in[i] = (const float*)d_in[i];
    a.out = (float*)d_out; a.ws = (unsigned char*)d_ws; a.ph_lo = 0; a.ph_hi = NPHASE;
    if (hipMemsetAsync((char*)d_ws + WS_CTL, 0, CTL_ZERO_BYTES, stream) != hipSuccess) { fprintf(stderr, "kernel_launch: hipMemsetAsync failed\n"); return; }
    void* kargs[] = {&a};
    const hipError_t e = hipLaunchCooperativeKernel((const void*)fwd, dim3(grid), dim3(NTHR), kargs, LDS_BYTES, stream);
    if (e != hipSuccess) fprintf(stderr, "kernel_launch: cooperative launch failed: %s (grid %d)\n", hipGetErrorString(e), grid);
}
```

```cpp
#define CODE_SHIFT_NOPS 8
#define CODE_SHIFT_STR "8"
#include <hip/hip_runtime.h>
#include <hip/hip_cooperative_groups.h>
namespace cg = cooperative_groups;
#include <cstdio>
#include <cstdint>
namespace pg8 {
#define PG8_LAS __attribute__((address_space(3)))
typedef unsigned short bf16_t;
typedef short bf16x8 __attribute__((ext_vector_type(8)));
typedef float f32x4 __attribute__((ext_vector_type(4)));
typedef unsigned u32x4 __attribute__((ext_vector_type(4)));
constexpr int BM = 256, BK = 64, HALF = 128, HTB = HALF * BK * 2  , STAGE_BYTES = 8 * HTB, NXCD = 8, WGM = 8;

__host__ __device__ __forceinline__ int lds_byte(int r, int c) { const int st = (r >> 4) * 2 + (c >> 5), rr = r & 15, cc = c & 31, ob = rr * 64 + cc * 2; return st * 1024 + (ob ^ (((ob >> 9) & 1) << 5)); }
__host__ __device__ __forceinline__ void stage_rc(int b, int& R, int& C) { const int st = b / 1024, sb = b % 1024, swz = sb ^ (((sb >> 9) & 1) << 5); R = (st >> 1) * 16 + swz / 64; C = (st & 1) * 32 + (swz % 64) / 2; }
__host__ __device__ __forceinline__ int perm32(int rho) { const int n = rho >> 4, i = rho & 15; return 8 * (i >> 2) + 4 * n + (i & 3); }

struct Unit { int pm, pn; };
struct Gemm { const bf16_t* A; const bf16_t* Bt; int M, N, K; };

struct StaticOrder {
    int nM, nN, nwg, G, c;
    __host__ __device__ void init(int M, int N, int G_, int c_) { nM = M / BM; nN = N / BM; nwg = nM * nN; G = G_; c = c_; }
    __host__ __device__ bool next(int i, Unit& u) const {
        const long L = (long)i * G + c; if (L >= nwg) return false;
        int wgid = (int)L; { const int q = nwg / NXCD, r = nwg % NXCD, xcd = wgid % NXCD, off = wgid / NXCD; wgid = (xcd < r ? xcd * (q + 1) : r * (q + 1) + (xcd - r) * q) + off; }
        const int nig = WGM * nN, gid = wgid / nig, fm = gid * WGM, gsz = (nM - fm) < WGM ? (nM - fm) : WGM;
        u.pm = fm + ((wgid % nig) % gsz); u.pn = (wgid % nig) / gsz; return true;
    }
    __device__ __forceinline__ void a_ready(const Unit&) const {}
    __device__ __forceinline__ void done(const Unit&) const {}
};

__device__ __forceinline__ unsigned cvt_pk_bf16(float lo, float hi) { unsigned r; asm volatile("v_cvt_pk_bf16_f32 %0, %1, %2" : "=v"(r) : "v"(lo), "v"(hi)); return r; }
typedef float f32x2 __attribute__((ext_vector_type(2)));

template <int ACT> struct EpiBf16 {
    static constexpr bool PERM = true, AFTER_DRAIN = false;
    bf16_t* O; int ldc; const float* ssq; int qk_lo, qk_mid, qk_hi; const float* gq; const float* gk; float qscale; PG8_LAS float* xl; bf16_t* att; int att_rows;
    __device__ __forceinline__ void operator()(const f32x4 (&acc)[2][2][4][2], const Unit& u, int wr, int wc, int fr, int fq) const {
        const int row0 = u.pm * BM + wr * 64 + fr; const int col0 = u.pn * BM + wc * 32 + 8 * fq;
        const bool qk = u.pn >= qk_lo && u.pn < qk_hi;
        float rsr[2][4];
#pragma unroll
        for (int ai = 0; ai < 2; ++ai)
#pragma unroll
            for (int m = 0; m < 4; ++m) rsr[ai][m] = 1.0f / sqrtf(ssq[row0 + ai * HALF + m * 16] * (1.0f / 2048.0f) + 1e-6f);
        f32x4 g0 = {1.f, 1.f, 1.f, 1.f}, g1 = {1.f, 1.f, 1.f, 1.f};
        if (qk) {
            const float* gp = (u.pn < qk_mid ? gq : gk) + wc * 32 + 8 * fq; const float sc = u.pn < qk_mid ? qscale : 1.0f;
            g0 = *(const f32x4*)gp * sc; g1 = *(const f32x4*)(gp + 4) * sc;
#pragma unroll
            for (int ai = 0; ai < 2; ++ai)
#pragma unroll
                for (int m = 0; m < 4; ++m)
#pragma unroll
                    for (int bj = 0; bj < 2; ++bj) { const f32x4 v0 = acc[ai][bj][m][0] * rsr[ai][m], v1 = acc[ai][bj][m][1] * rsr[ai][m];
                        float s = ((v0[0] * v0[0] + v0[1] * v0[1]) + (v0[2] * v0[2] + v0[3] * v0[3])) + ((v1[0] * v1[0] + v1[1] * v1[1]) + (v1[2] * v1[2] + v1[3] * v1[3]));
                        s += __shfl_xor(s, 16); s += __shfl_xor(s, 32);
                        if (fq == 0) xl[((((wr * 2 + ai) * 4 + m) * 2 + bj) * 16 + fr) * 4 + wc] = s; }
            asm volatile("s_waitcnt lgkmcnt(0)" ::: "memory"); __builtin_amdgcn_s_barrier(); asm volatile("" ::: "memory");
        }
#pragma unroll
        for (int ai = 0; ai < 2; ++ai)
#pragma unroll
            for (int m = 0; m < 4; ++m) { const int row = row0 + ai * HALF + m * 16;
                bf16_t* rowp = u.pn < qk_lo ? O + (size_t)row * ldc + col0 : att + ((size_t)(2 * (u.pn - qk_lo)) * att_rows + row) * 128 + wc * 32 + 8 * fq;
                const size_t hstride = u.pn < qk_lo ? (size_t)HALF : (size_t)att_rows * 128;
#pragma unroll
                for (int bj = 0; bj < 2; ++bj) { float rs = rsr[ai][m];
                    if (qk) { const f32x4 p = *(const PG8_LAS f32x4*)(xl + ((((wr * 2 + ai) * 4 + m) * 2 + bj) * 16 + fr) * 4); rs *= 1.0f / sqrtf(((p[0] + p[1]) + (p[2] + p[3])) * (1.0f / 128.0f) + 1e-6f); }
                    const f32x4 v0 = acc[ai][bj][m][0] * rs * g0, v1 = acc[ai][bj][m][1] * rs * g1;
                    u32x4 w; w.x = cvt_pk_bf16(v0[0], v0[1]); w.y = cvt_pk_bf16(v0[2], v0[3]); w.z = cvt_pk_bf16(v1[0], v1[1]); w.w = cvt_pk_bf16(v1[2], v1[3]);
                    *(u32x4*)(rowp + bj * hstride) = w; } }
    }
};
template <bool BASE_F32> struct EpiResB {
    static constexpr bool PERM = true, AFTER_DRAIN = false;
    const float* basf; const bf16_t* basb; bf16_t* xb; int ldc; float* ssq;
    __device__ __forceinline__ void operator()(const f32x4 (&acc)[2][2][4][2], const Unit& u, int wr, int wc, int fr, int fq) const {
        const int row0 = u.pm * BM + wr * 64 + fr, col0 = u.pn * BM + wc * 32 + 8 * fq;
#pragma unroll
        for (int ai = 0; ai < 2; ++ai)
#pragma unroll
            for (int m = 0; m < 4; ++m) { const int row = row0 + ai * HALF + m * 16; const size_t off = (size_t)row * ldc + col0; float ss = 0.f;
#pragma unroll
                for (int bj = 0; bj < 2; ++bj) { f32x4 o0, o1;
                    if (BASE_F32) { o0 = *(const f32x4*)(basf + off + bj * HALF) + acc[ai][bj][m][0]; o1 = *(const f32x4*)(basf + off + bj * HALF + 4) + acc[ai][bj][m][1]; }
                    else { const u32x4 bw = *(const u32x4*)(basb + off + bj * HALF);
                        o0 = (f32x4){__builtin_bit_cast(float, bw.x << 16), __builtin_bit_cast(float, bw.x & 0xffff0000u), __builtin_bit_cast(float, bw.y << 16), __builtin_bit_cast(float, bw.y & 0xffff0000u)} + acc[ai][bj][m][0];
                        o1 = (f32x4){__builtin_bit_cast(float, bw.z << 16), __builtin_bit_cast(float, bw.z & 0xffff0000u), __builtin_bit_cast(float, bw.w << 16), __builtin_bit_cast(float, bw.w & 0xffff0000u)} + acc[ai][bj][m][1]; }
                    ss += ((o0[0] * o0[0] + o0[1] * o0[1]) + (o0[2] * o0[2] + o0[3] * o0[3])) + ((o1[0] * o1[0] + o1[1] * o1[1]) + (o1[2] * o1[2] + o1[3] * o1[3]));
                    u32x4 w; w.x = cvt_pk_bf16(o0[0], o0[1]); w.y = cvt_pk_bf16(o0[2], o0[3]); w.z = cvt_pk_bf16(o1[0], o1[1]); w.w = cvt_pk_bf16(o1[2], o1[3]);
                    *(u32x4*)(xb + off + bj * HALF) = w; }
                ss += __shfl_xor(ss, 16); ss += __shfl_xor(ss, 32);
                if (fq == 0) atomicAdd(ssq + row, ss);
                asm volatile("" ::: "memory"); }
    }
};
struct EpiResF {
    static constexpr bool PERM = false, AFTER_DRAIN = false;
    const bf16_t* basb; float* out; int ldc;
    __device__ __forceinline__ void operator()(const f32x4 (&acc)[2][2][4][2], const Unit& u, int wr, int wc, int fr, int fq) const {
        typedef unsigned u32x2v __attribute__((ext_vector_type(2)));
        const int row0 = u.pm * BM + wr * 64 + fr, col0 = u.pn * BM + wc * 32 + 4 * fq;
#pragma unroll
        for (int ai = 0; ai < 2; ++ai)
#pragma unroll
            for (int m = 0; m < 4; ++m) { const size_t off = (size_t)(row0 + ai * HALF + m * 16) * ldc + col0;
#pragma unroll
                for (int bj = 0; bj < 2; ++bj)
#pragma unroll
                    for (int n = 0; n < 2; ++n) { const u32x2v bw = *(const u32x2v*)(basb + off + bj * HALF + n * 16);
                        const f32x4 b = {__builtin_bit_cast(float, bw.x << 16), __builtin_bit_cast(float, bw.x & 0xffff0000u), __builtin_bit_cast(float, bw.y << 16), __builtin_bit_cast(float, bw.y & 0xffff0000u)};
                        *(f32x4*)(out + off + bj * HALF + n * 16) = b + acc[ai][bj][m][n]; }
                asm volatile("" ::: "memory"); }
    }
};
struct EpiSwiglu {
    static constexpr bool PERM = true, AFTER_DRAIN = false;
    bf16_t* O; int ldh; const float* ssq;
    __device__ __forceinline__ void operator()(const f32x4 (&acc)[2][2][4][2], const Unit& u, int wr, int wc, int fr, int fq) const {
        typedef unsigned u32x2v __attribute__((ext_vector_type(2)));
        const int row0 = u.pm * BM + wr * 64 + fr; const int h0 = u.pn * 128 + wc * 16 + 4 * fq;
#pragma unroll
        for (int ai = 0; ai < 2; ++ai)
#pragma unroll
            for (int m = 0; m < 4; ++m) { const int row = row0 + ai * HALF + m * 16; bf16_t* rowp = O + (size_t)row * ldh + h0;
                const float rs = 1.0f / sqrtf(ssq[row] * (1.0f / 2048.0f) + 1e-6f);
#pragma unroll
                for (int bj = 0; bj < 2; ++bj) { const f32x4 g = acc[ai][bj][m][0] * rs, up = acc[ai][bj][m][1] * rs; float v[4];
#pragma unroll
                    for (int e = 0; e < 4; ++e) v[e] = g[e] * __builtin_amdgcn_rcpf(1.0f + __expf(-g[e])) * up[e];
                    u32x2v w; w.x = cvt_pk_bf16(v[0], v[1]); w.y = cvt_pk_bf16(v[2], v[3]);
                    *(u32x2v*)(rowp + bj * 64) = w; } }
    }
};
template <class Epi, class Sched, bool ALIGN_EPI = false, bool SP2 = false>
__device__ __forceinline__ void gemm_phase(PG8_LAS unsigned char* lds, const Gemm g, const Sched& S, const Epi& E) {
    const int tid = threadIdx.x, wid = __builtin_amdgcn_readfirstlane(tid >> 6), lane = tid & 63, wr = wid >> 2, wc = wid & 3, fr = lane & 15, fq = lane >> 4;
    const int K = g.K, nt = K / BK;
    unsigned voffA[2], voffB[2];
#pragma unroll
    for (int i = 0; i < 2; ++i) { int R, C; stage_rc(tid * 16 + i * 8192, R, C); const int Rb = Epi::PERM ? ((R & ~31) + perm32(R & 31)) : R;
        voffA[i] = (unsigned)(R * K + C) * 2u; voffB[i] = (unsigned)(Rb * K + C) * 2u; }
    const size_t kstep = (size_t)(BK * 2);
    const size_t hstep = (size_t)HALF * K * 2;
    const size_t tstep = 2 * hstep;
    const unsigned ldsw = (unsigned)wid * 1024u;
    const int aoff = lds_byte(wr * 64 + fr, fq * 8), boff = lds_byte(wc * 32 + fr, fq * 8);
#define PG8_SA(b, h) (((b) * 2 + (h)) * HTB)
#define PG8_SB(b, h) ((4 + (b) * 2 + (h)) * HTB)
#define PG8_STAGE(bufoff, gbase, voff) do { _Pragma("unroll") for (int _i = 0; _i < 2; ++_i) \
        __builtin_amdgcn_global_load_lds((const unsigned*)((const char*)(gbase) + (voff)[_i]), (PG8_LAS unsigned*)(lds + (bufoff) + ldsw + _i * 8192), 16, 0, 0); } while (0)
#define PG8_LDA(dst, b, h) do { _Pragma("unroll") for (int m = 0; m < 4; ++m) _Pragma("unroll") for (int k = 0; k < 2; ++k) dst[m][k] = *(const PG8_LAS bf16x8*)(lds + PG8_SA(b, h) + aoff + m * 2048 + k * 1024); } while (0)
#define PG8_LDB(dst, b, h) do { _Pragma("unroll") for (int n = 0; n < 2; ++n) _Pragma("unroll") for (int k = 0; k < 2; ++k) dst[n][k] = *(const PG8_LAS bf16x8*)(lds + PG8_SB(b, h) + boff + n * 2048 + k * 1024); } while (0)
#define PG8_MMA(ai, bj, At, Bt) do { __builtin_amdgcn_s_setprio(1); _Pragma("unroll") for (int m = 0; m < 4; ++m) _Pragma("unroll") for (int n = 0; n < 2; ++n) _Pragma("unroll") for (int k = 0; k < 2; ++k) \
        acc[ai][bj][m][n] = __builtin_amdgcn_mfma_f32_16x16x32_bf16(Bt[n][k], At[m][k], acc[ai][bj][m][n], 0, 0, 0); __builtin_amdgcn_s_setprio(0); } while (0)
#define PG8_WAIT_V(n) asm volatile("s_waitcnt vmcnt(" #n ")" ::: "memory")
#define PG8_WAIT_L(n) asm volatile("s_waitcnt lgkmcnt(" #n ")" ::: "memory")
#define PG8_BAR __builtin_amdgcn_s_barrier()
#define PG8_SCHED __builtin_amdgcn_sched_barrier(0)
    Unit cur, nxt; int ui = 0;
    if (!S.next(0, cur)) return;
    f32x4 acc[2][2][4][2];
#pragma unroll
    for (int a = 0; a < 2; ++a)
#pragma unroll
        for (int b = 0; b < 2; ++b)
#pragma unroll
            for (int m = 0; m < 4; ++m)
#pragma unroll
                for (int n = 0; n < 2; ++n) acc[a][b][m][n] = (f32x4){0.f, 0.f, 0.f, 0.f};
    bf16x8 At[4][2], B0[2][2], B1[2][2];
    const char* cA = (const char*)g.A + (size_t)cur.pm * tstep; const char* cB = (const char*)g.Bt + (size_t)cur.pn * tstep;
    S.a_ready(cur);
    if constexpr (SP2) {
        PG8_STAGE(PG8_SB(0, 0), cB, voffB); PG8_STAGE(PG8_SB(0, 1), cB + hstep, voffB); PG8_STAGE(PG8_SA(0, 0), cA, voffA); PG8_STAGE(PG8_SA(0, 1), cA + hstep, voffA);
        if (wr == 1) PG8_BAR;
        PG8_WAIT_V(2); PG8_BAR;
        PG8_STAGE(PG8_SB(1, 0), cB + kstep, voffB); PG8_STAGE(PG8_SA(1, 0), cA + kstep, voffA); PG8_STAGE(PG8_SB(1, 1), cB + hstep + kstep, voffB);
        PG8_WAIT_V(6); PG8_BAR;
    } else {
        PG8_STAGE(PG8_SB(0, 0), cB, voffB); PG8_STAGE(PG8_SA(0, 0), cA, voffA); PG8_STAGE(PG8_SB(0, 1), cB + hstep, voffB); PG8_STAGE(PG8_SA(0, 1), cA + hstep, voffA);
        if (wr == 1) PG8_BAR;
        PG8_WAIT_V(4); PG8_BAR;
        PG8_STAGE(PG8_SB(1, 0), cB + kstep, voffB); PG8_STAGE(PG8_SA(1, 0), cA + kstep, voffA); PG8_STAGE(PG8_SB(1, 1), cB + hstep + kstep, voffB);
        PG8_WAIT_V(6); PG8_BAR;
    }
    for (;;) {
        const bool has_next = S.next(ui + 1, nxt);
        const char* nA = has_next ? (const char*)g.A + (size_t)nxt.pm * tstep : cA; const char* nB = has_next ? (const char*)g.Bt + (size_t)nxt.pn * tstep : cB;
        for (int t = 0; t < nt; t += 2) {
            const bool last = (t == nt - 2);
            const char* a1 = cA + (size_t)(t + 1) * kstep;
            const char* a2 = last ? nA : cA + (size_t)(t + 2) * kstep; const char* b2 = last ? nB : cB + (size_t)(t + 2) * kstep;
            const char* a3 = a2 + kstep; const char* b3 = b2 + kstep;
            if (last && has_next) S.a_ready(nxt);
            if constexpr (SP2) {
            PG8_LDB(B0, 0, 0); PG8_LDB(B1, 0, 1); PG8_SCHED; PG8_LDA(At, 0, 0); PG8_STAGE(PG8_SA(1, 1), a1 + hstep, voffA);
            PG8_WAIT_V(8); PG8_WAIT_L(0); PG8_BAR; PG8_MMA(0, 0, At, B0); PG8_MMA(0, 1, At, B1); PG8_BAR; PG8_SCHED;
            PG8_LDA(At, 0, 1); PG8_STAGE(PG8_SB(0, 0), b2, voffB); PG8_STAGE(PG8_SB(0, 1), b2 + hstep, voffB); PG8_STAGE(PG8_SA(0, 0), a2, voffA);
            PG8_WAIT_V(8); PG8_WAIT_L(0); PG8_BAR; PG8_MMA(1, 0, At, B0); PG8_MMA(1, 1, At, B1); PG8_BAR; PG8_SCHED;
            PG8_LDB(B0, 1, 0); PG8_LDB(B1, 1, 1); PG8_SCHED; PG8_LDA(At, 1, 0); PG8_STAGE(PG8_SA(0, 1), a2 + hstep, voffA);
            PG8_WAIT_V(8); PG8_WAIT_L(0); PG8_BAR; PG8_MMA(0, 0, At, B0); PG8_MMA(0, 1, At, B1); PG8_BAR; PG8_SCHED;
            PG8_LDA(At, 1, 1); PG8_STAGE(PG8_SB(1, 0), b3, voffB); PG8_STAGE(PG8_SB(1, 1), b3 + hstep, voffB); PG8_STAGE(PG8_SA(1, 0), a3, voffA);
            PG8_WAIT_V(8); PG8_WAIT_L(0); PG8_BAR; PG8_MMA(1, 0, At, B0); PG8_MMA(1, 1, At, B1); PG8_BAR; PG8_SCHED;
            } else {
            PG8_LDB(B0, 0, 0); PG8_SCHED; PG8_LDA(At, 0, 0); PG8_STAGE(PG8_SA(1, 1), a1 + hstep, voffA);
            PG8_WAIT_L(8); PG8_BAR; PG8_WAIT_L(0); PG8_MMA(0, 0, At, B0); PG8_BAR; PG8_SCHED;
            PG8_LDB(B1, 0, 1); PG8_STAGE(PG8_SB(0, 0), b2, voffB);
            PG8_BAR; PG8_WAIT_L(0); PG8_MMA(0, 1, At, B1); PG8_BAR;
            PG8_LDA(At, 0, 1); PG8_STAGE(PG8_SA(0, 0), a2, voffA);
            PG8_BAR; PG8_WAIT_L(0); PG8_MMA(1, 0, At, B0); PG8_BAR; PG8_SCHED;
            PG8_STAGE(PG8_SB(0, 1), b2 + hstep, voffB);
            PG8_WAIT_V(6); PG8_BAR; PG8_MMA(1, 1, At, B1); PG8_BAR;
            PG8_LDB(B0, 1, 0); PG8_SCHED; PG8_LDA(At, 1, 0); PG8_STAGE(PG8_SA(0, 1), a2 + hstep, voffA);
            PG8_WAIT_L(8); PG8_BAR; PG8_WAIT_L(0); PG8_MMA(0, 0, At, B0); PG8_BAR; PG8_SCHED;
            PG8_LDB(B1, 1, 1); PG8_STAGE(PG8_SB(1, 0), b3, voffB);
            PG8_BAR; PG8_WAIT_L(0); PG8_MMA(0, 1, At, B1); PG8_BAR;
            PG8_LDA(At, 1, 1); PG8_STAGE(PG8_SA(1, 0), a3, voffA);
            PG8_BAR; PG8_WAIT_L(0); PG8_MMA(1, 0, At, B0); PG8_BAR; PG8_SCHED;
            PG8_STAGE(PG8_SB(1, 1), b3 + hstep, voffB);
            PG8_WAIT_V(6); PG8_BAR; PG8_MMA(1, 1, At, B1); PG8_BAR;
            }
        }
        if constexpr (ALIGN_EPI) { if (wr == 0) PG8_BAR; }
        if constexpr (!Epi::AFTER_DRAIN) { E(acc, cur, wr, wc, fr, fq); S.done(cur); }
        if (!has_next) break;
#pragma unroll
        for (int a = 0; a < 2; ++a)
#pragma unroll
            for (int b = 0; b < 2; ++b)
#pragma unroll
                for (int m = 0; m < 4; ++m)
#pragma unroll
                    for (int n = 0; n < 2; ++n) acc[a][b][m][n] = (f32x4){0.f, 0.f, 0.f, 0.f};
        cur = nxt; cA = nA; cB = nB; ++ui;
        if constexpr (ALIGN_EPI) { if (wr == 1) PG8_BAR; }
    }
    PG8_WAIT_V(0);
    if constexpr (!ALIGN_EPI) { if (wr == 0) PG8_BAR; }
    PG8_BAR;
    if constexpr (Epi::AFTER_DRAIN) { E.fused(acc, cur, wr, wc, fr, fq, lds, wid, lane); S.done(cur); }
#undef PG8_SA
#undef PG8_SB
#undef PG8_STAGE
#undef PG8_LDA
#undef PG8_LDB
#undef PG8_MMA
#undef PG8_WAIT_V
#undef PG8_WAIT_L
#undef PG8_BAR
#undef PG8_SCHED
}
}

#define LAS __attribute__((address_space(3)))
typedef unsigned short bf16;
typedef unsigned v4u __attribute__((ext_vector_type(4)));
typedef unsigned v2u __attribute__((ext_vector_type(2)));
typedef float f32x4 __attribute__((ext_vector_type(4)));
constexpr int NWAVES = 8, NTHR = 512;
constexpr int DM = 2048, NB = 4, SEQ = 2048, T = NB * SEQ, DEPTH = 2;
constexpr int NIN = 6160, NPROJ = 6144, FFN = 5632, NGU = 2 * FFN;
constexpr int LDP = 3072;
constexpr int C_QA = 0, C_KA = 512, C_VA = 1024, C_RA = 2048, C_QB = 3072, C_KB = 4096, C_VB = 5120;
constexpr float RMS_EPS = 1e-6f;
constexpr size_t MiB = 1u << 20;
constexpr size_t WS_MB = 49152;
constexpr size_t WS_CTL = 0, CTL_ZERO_BYTES = 65536;
constexpr size_t WS_WIN = 1 * MiB, WS_WOUT = 49 * MiB, WS_WGU = 65 * MiB, WS_WD = 153 * MiB, WS_XB = 197 * MiB, WS_PROJ = 229 * MiB, WS_HMID = 229 * MiB,
                 WS_GA = 325 * MiB, WS_MIX = 326 * MiB, WS_QT = 358 * MiB, WS_KD = 366 * MiB, WS_VT = 374 * MiB, WS_PT = 390 * MiB, WS_DEC = 394 * MiB, WS_SN = 395 * MiB, WS_WGA = 427 * MiB, WS_SSQ = 428 * MiB, WS_OP2 = 429 * MiB, WS_LP = 445 * MiB, WS_END = 446 * MiB;
constexpr size_t SZ_WIN = (size_t)NPROJ * DM * 2, SZ_WOUT = (size_t)DM * DM * 2, SZ_WGU = (size_t)NGU * DM * 2, SZ_WD = (size_t)DM * FFN * 2;
static_assert(WS_WIN + 2 * SZ_WIN <= WS_WOUT && WS_WOUT + 2 * SZ_WOUT <= WS_WGU && WS_WGU + 2 * SZ_WGU <= WS_WD && WS_WD + 2 * SZ_WD <= WS_XB, "ws map (weights)");
static_assert(WS_XB + (size_t)T * DM * 2 <= WS_PROJ && WS_PROJ + (size_t)T * NPROJ * 2 <= WS_GA && WS_HMID + (size_t)T * FFN * 2 <= WS_GA && WS_GA + (size_t)T * 16 * 4 <= WS_MIX && WS_MIX + (size_t)T * DM * 2 <= WS_QT, "ws map (activations)");
constexpr int LDS_BYTES = 147456;

__device__ const unsigned char kBucket[3][129] = {
 {0,1,2,3,4,5,6,7,8,9,10,11,12,13,14,15,16,16,16,16,16,16,17,17,17,17,17,17,17,17,18,18,18,18,18,18,18,18,18,18,19,19,19,19,19,19,19,19,19,19,19,19,19,19,20,20,20,20,20,20,20,20,20,20,20,20,20,20,20,20,20,20,20,21,21,21,21,21,21,21,21,21,21,21,21,21,21,21,21,21,21,21,21,21,21,21,21,21,21,22,22,22,22,22,22,22,22,22,22,22,22,22,22,22,22,22,22,22,22,22,22,22,22,22,22,22,22,22,22},
 {0,4,8,12,16,16,17,17,18,18,19,19,19,19,20,20,20,20,20,21,21,21,21,21,21,22,22,22,22,22,22,22,22,22,23,23,23,23,23,23,23,23,23,23,23,23,24,24,24,24,24,24,24,24,24,24,24,24,24,24,24,24,25,25,25,25,25,25,25,25,25,25,25,25,25,25,25,25,25,25,25,25,25,26,26,26,26,26,26,26,26,26,26,26,26,26,26,26,26,26,26,26,26,26,26,26,26,26,26,26,26,26,26,27,27,27,27,27,27,27,27,27,27,27,27,27,27,27,27},
 {0,16,18,19,20,21,21,22,22,23,23,23,24,24,24,24,25,25,25,25,25,26,26,26,26,26,26,26,26,27,27,27,27,27,27,27,27,27,27,28,28,28,28,28,28,28,28,28,28,28,28,28,29,29,29,29,29,29,29,29,29,29,29,29,29,29,29,29,29,29,30,30,30,30,30,30,30,30,30,30,30,30,30,30,30,30,30,30,30,30,30,30,30,30,30,31,31,31,31,31,31,31,31,31,31,31,31,31,31,31,31,31,31,31,31,31,31,31,31,31,31,31,31,31,31,31,31,31,31}};

#define LDS_WAIT() asm volatile("s_waitcnt lgkmcnt(0)" ::: "memory")
#define LDS_BARRIER() do { asm volatile("s_waitcnt lgkmcnt(0)" ::: "memory"); __builtin_amdgcn_s_barrier(); asm volatile("" ::: "memory"); } while (0)
typedef float f32x2_t __attribute__((ext_vector_type(2))); typedef __bf16 bf16x2_t __attribute__((ext_vector_type(2)));
__device__ __forceinline__ unsigned pk2(float lo, float hi) { const f32x2_t v = {lo, hi}; return __builtin_bit_cast(unsigned, __builtin_convertvector(v, bf16x2_t)); }
__device__ __forceinline__ unsigned f2bf(float f) { return pk2(f, 0.f) & 0xffffu; }
__device__ __forceinline__ float bf2f(unsigned h) { return __builtin_bit_cast(float, h << 16); }
__device__ __forceinline__ float bflo(unsigned w) { return __builtin_bit_cast(float, w << 16); }
__device__ __forceinline__ float bfhi(unsigned w) { return __builtin_bit_cast(float, w & 0xffff0000u); }
__device__ __forceinline__ float wave_sum(float v) {
#pragma unroll
    for (int o = 1; o < 64; o <<= 1) v += __shfl_xor(v, o);
    return v;
}

#define XB_TMO      128
#define XB_XCNT(j)  (256  + 64 * (j))
#define XB_XSUB(j)  (1280 + 64 * (j))
#define XB_XGEN(j)  (2304 + 64 * (j))
#define XB_TOP      3328
#define XB_TOPGEN   3392
#define XCD_BAR_WORDS 3456
#define XB_SPIN_CAP (1u << 18)

__device__ __forceinline__ unsigned xb_ld(unsigned* p)              { return __hip_atomic_load(p, __ATOMIC_RELAXED, __HIP_MEMORY_SCOPE_AGENT); }
__device__ __forceinline__ unsigned xb_add(unsigned* p, unsigned v) { return __hip_atomic_fetch_add(p, v, __ATOMIC_RELAXED, __HIP_MEMORY_SCOPE_AGENT); }
__device__ __forceinline__ unsigned xb_xcc_id() { return (unsigned)__builtin_amdgcn_s_getreg((3 << 11) | 20) & 0xFu; }
#define XB_SPIN(cond, bar) do { unsigned _sp = 0; while (cond) { __builtin_amdgcn_s_sleep(1); \
    if ((++_sp & 255u) == 0u) { if (xb_ld(&(bar)[XB_TMO])) break; if (_sp > XB_SPIN_CAP) { atomicAdd(&(bar)[XB_TMO], 1u); break; } } } } while (0)

#ifndef CODE_AHEAD
#define CODE_AHEAD 32768
#endif
struct XcdBarrier {
    unsigned* bar; unsigned x;
    volatile LAS unsigned* st;
};

__device__ __forceinline__ XcdBarrier xcd_barrier_post(unsigned* bar, volatile LAS unsigned* st) {
    XcdBarrier b; b.bar = bar; b.x = xb_xcc_id(); b.st = st;
    if (threadIdx.x == 0) (void)xb_add(&bar[XB_XCNT(b.x)], 1u);
    return b;
}
__device__ __forceinline__ void xcd_barrier_complete(unsigned* bar, unsigned x, unsigned& nloc, unsigned& nx) {
    const unsigned G = gridDim.x * gridDim.y * gridDim.z;
    unsigned sum, cnt, mine, sp = 0u;
    for (;;) {
        sum = 0u; cnt = 0u; mine = 0u;
#pragma unroll
        for (unsigned j = 0; j < 16; ++j) { const unsigned c = xb_ld(&bar[XB_XCNT(j)]); sum += c; cnt += (c > 0u) ? 1u : 0u; mine = (j == x) ? c : mine; }
        if (sum == G) break;
        __builtin_amdgcn_s_sleep(1);
        if ((++sp & 255u) == 0u) { if (xb_ld(&bar[XB_TMO])) break; if (sp > XB_SPIN_CAP) { atomicAdd(&bar[XB_TMO], 1u); break; } }
    }
    nloc = mine > 0u ? mine : 1u; nx = cnt > 0u ? cnt : 1u;
}

__device__ __forceinline__ void xcd_arrive(const XcdBarrier& b) {
    asm volatile("s_waitcnt vmcnt(0)" ::: "memory");
    __syncthreads();
    if (threadIdx.x == 0) {
        unsigned* bar = b.bar;
        __builtin_amdgcn_s_waitcnt(0);
        unsigned nloc = b.st[0], nx = b.st[1];
        if (nloc == 0u) { xcd_barrier_complete(bar, b.x, nloc, nx); b.st[0] = nloc; b.st[1] = nx; }
        const unsigned old = xb_add(&bar[XB_XSUB(b.x)], 1u);
        const unsigned gen = old / nloc;
        b.st[2] = (gen + 1u) * nx;
        asm volatile("buffer_inv sc1" ::: "memory");
        if (old + 1u == (gen + 1u) * nloc) {
            __builtin_amdgcn_fence(__ATOMIC_RELEASE, "agent");
            asm volatile("s_waitcnt vmcnt(0)" ::: "memory");
            (void)xb_add(&bar[XB_TOP], 1u);
        }
    }
    {   unsigned long long pc; asm volatile("s_getpc_b64 %0" : "=s"(pc));
        if (threadIdx.x < CODE_AHEAD / 128) { const unsigned* p = (const unsigned*)(pc + (unsigned long long)threadIdx.x * 128u); unsigned v;
            asm volatile("global_load_dword %0, %1, off\n\ts_waitcnt vmcnt(0)" : "=v"(v) : "v"(p) : "memory"); } }
}
__device__ __forceinline__ void xcd_wait(const XcdBarrier& b) {
    __syncthreads();
    if (threadIdx.x == 0) {
        unsigned* bar = b.bar;
        const unsigned target = b.st[2];
        XB_SPIN((int)(xb_ld(&bar[XB_TOP]) - target) < 0, bar);
        asm volatile("s_waitcnt vmcnt(0)" ::: "memory");
    }
    __syncthreads();
}
__device__ __forceinline__ void xcd_barrier(const XcdBarrier& b) { xcd_arrive(b); xcd_wait(b); }


struct Ctx {
    LAS unsigned char* lds; int tid, lane, wave, G, bid;
    const float *x, *norm1_g, *w_in, *gate_w2, *gate_b, *onorm_g, *qn_g, *kn_g, *rel_bias, *w_out, *norm2_g, *w_gate, *w_up, *w_down;
    float* out; unsigned char* ws;
    XcdBarrier bar;
};

struct ConvItem { const float* src; bf16* dst; const float* gk; int ldw, K, mode, n0; };
__device__ __forceinline__ ConvItem conv_item_of(const Ctx& F, int it) {
    constexpr int I_IN = (DM / 128) * (NPROJ / 256), I_OUT = (DM / 128) * (DM / 256), I_G = (DM / 128) * (FFN / 256), I_D = (FFN / 128) * (DM / 256);
    constexpr int PER_LAYER = I_IN + I_OUT + 2 * I_G + I_D;
    const int l = it / PER_LAYER; int r = it % PER_LAYER; ConvItem c; c.gk = nullptr; c.mode = 0;
    if (r < I_IN) { const int nblk = NPROJ / 256, kb = r / nblk, n0 = 256 * (r % nblk); const int src0 = n0 + (n0 >= 3072 ? 16 : 0);
        c.src = F.w_in + ((size_t)l * DM + 128 * kb) * NIN + src0; c.ldw = NIN; c.dst = (bf16*)(F.ws + WS_WIN + l * SZ_WIN) + 128 * kb; c.K = DM; c.n0 = n0; c.gk = F.norm1_g + l * DM + 128 * kb; return c; }
    r -= I_IN;
    if (r < I_OUT) { const int nblk = DM / 256, kb = r / nblk, n0 = 256 * (r % nblk);
        c.src = F.w_out + ((size_t)l * DM + 128 * kb) * DM + n0; c.ldw = DM; c.dst = (bf16*)(F.ws + WS_WOUT + l * SZ_WOUT) + 128 * kb; c.K = DM; c.n0 = n0; return c; }
    r -= I_OUT;
    if (r < 2 * I_G) { const int up = r >= I_G; if (up) r -= I_G; const int nblk = FFN / 256, kb = r / nblk, n0 = 256 * (r % nblk);
        c.src = (up ? F.w_up : F.w_gate) + ((size_t)l * DM + 128 * kb) * FFN + n0; c.ldw = FFN; c.dst = (bf16*)(F.ws + WS_WGU + l * SZ_WGU) + 128 * kb; c.K = DM; c.n0 = n0; c.mode = 1 + up; c.gk = F.norm2_g + l * DM + 128 * kb; return c; }
    r -= 2 * I_G;
    { const int nblk = DM / 256, kb = r / nblk, n0 = 256 * (r % nblk);
        c.src = F.w_down + ((size_t)l * FFN + 128 * kb) * DM + n0; c.ldw = DM; c.dst = (bf16*)(F.ws + WS_WD + l * SZ_WD) + 128 * kb; c.K = FFN; c.n0 = n0; return c; }
}
__device__ __forceinline__ void conv_load(const ConvItem& c, f32x4 (&v)[16], int tid) {
    const int r8 = tid >> 6, c4 = tid & 63;
#pragma unroll
    for (int i = 0; i < 16; ++i) v[i] = *(const f32x4*)(c.src + (size_t)(8 * i + r8) * c.ldw + 4 * c4);
}
__device__ __forceinline__ void conv_store(const ConvItem& c, const f32x4 (&v)[16], LAS float* scr, int tid) {
    const int r8 = tid >> 6, c4 = tid & 63;
#pragma unroll
    for (int i = 0; i < 16; ++i) { LAS float* p = scr + (8 * i + r8) * 257 + 4 * c4; const float gs = c.gk ? c.gk[8 * i + r8] : 1.0f; p[0] = v[i].x * gs; p[1] = v[i].y * gs; p[2] = v[i].z * gs; p[3] = v[i].w * gs; }
    __syncthreads();
    const int cc = tid & 15, nr = tid >> 4;
#pragma unroll
    for (int j = 0; j < 8; ++j) { const int n = nr + 32 * j; const LAS float* sp = scr + (8 * cc) * 257 + n;
        v4u o; o.x = pk2(sp[0 * 257], sp[1 * 257]); o.y = pk2(sp[2 * 257], sp[3 * 257]); o.z = pk2(sp[4 * 257], sp[5 * 257]); o.w = pk2(sp[6 * 257], sp[7 * 257]);
        const int h = c.n0 + n; const int row = c.mode == 0 ? h : ((h >> 2) * 8 + (h & 3) + 4 * (c.mode - 1));
        *(v4u*)(c.dst + (size_t)row * c.K + 8 * cc) = o; }
    __syncthreads();
}
__device__ __forceinline__ void phase_convert(const Ctx& F) {
    LAS float* scr = (LAS float*)F.lds;
    constexpr int NITEMS = DEPTH * ((DM / 128) * (NPROJ / 256) + (DM / 128) * (DM / 256) + 2 * (DM / 128) * (FFN / 256) + (FFN / 128) * (DM / 256));
    {   f32x4 va[16], vb[16]; int it = F.bid;
        ConvItem ca = conv_item_of(F, it < NITEMS ? it : 0), cb = ca;
        if (it < NITEMS) conv_load(ca, va, F.tid);
#pragma unroll 1
        while (it < NITEMS) {
            const int itb = it + F.G; if (itb < NITEMS) { cb = conv_item_of(F, itb); conv_load(cb, vb, F.tid); }
            conv_store(ca, va, scr, F.tid);
            if (itb >= NITEMS) break;
            const int ita = itb + F.G; if (ita < NITEMS) { ca = conv_item_of(F, ita); conv_load(ca, va, F.tid); }
            conv_store(cb, vb, scr, F.tid);
            it = ita;
        }
    }
    const int gt = F.bid * NTHR + F.tid, NGT = F.G * NTHR;
    for (int i = gt; i < DEPTH * 16 * DM; i += NGT) { const int l = i / (16 * DM), j = (i / DM) & 15, k = i % DM;
        ((bf16*)(F.ws + WS_WGA))[i] = (bf16)f2bf(F.norm1_g[l * DM + k] * F.w_in[((size_t)l * DM + k) * NIN + 3072 + j]); }
    for (int i = gt; i < 4 * T; i += NGT) ((float*)(F.ws + WS_SSQ))[T + i] = 0.f;
    if (F.bid == F.G - 1) {
        LAS float* red = (LAS float*)F.lds;
        __syncthreads();
        if (F.wave < DEPTH) { const float* qg = F.qn_g + F.wave * 128; const float* kg = F.kn_g + F.wave * 128;
            float v = fmaxf(fabsf(qg[F.lane] * kg[F.lane]), fabsf(qg[F.lane + 64] * kg[F.lane + 64]));
#pragma unroll
            for (int o = 1; o < 64; o <<= 1) v = fmaxf(v, __shfl_xor(v, o));
            if (F.lane == 0) red[F.wave] = v; }
        if (F.wave == DEPTH) { const int h = F.lane & 7, kg4 = F.lane >> 3; float v = -INFINITY;
#pragma unroll
            for (int k = 0; k < 4; ++k) v = fmaxf(v, F.rel_bias[(4 * kg4 + k) * 8 + h]);
            v = fmaxf(v, __shfl_xor(v, 8)); v = fmaxf(v, __shfl_xor(v, 16)); v = fmaxf(v, __shfl_xor(v, 32));
            if (F.lane < 8) red[DEPTH + F.lane] = v; }
        __syncthreads();
        if (F.tid < DEPTH * 8) ((float*)(F.ws + WS_MB))[F.tid] = red[F.tid >> 3] * 11.313708498984761f * 1.02f + red[DEPTH + (F.tid & 7)];
    }
}

__device__ __forceinline__ void phase_norm(const Ctx& F, const float* x, bf16* xb, float* ssq) {
    const int gw = F.bid * NWAVES + F.wave, NGW = F.G * NWAVES, lane = F.lane;
    for (int m = gw; m < T; m += NGW) {
        const f32x4* xr = (const f32x4*)(x + (size_t)m * DM) + lane;
        f32x4 v[8]; float s = 0.f;
#pragma unroll
        for (int j = 0; j < 8; ++j) { v[j] = xr[64 * j]; s += (v[j].x * v[j].x + v[j].y * v[j].y) + (v[j].z * v[j].z + v[j].w * v[j].w); }
        s = wave_sum(s);
        v2u* o8 = (v2u*)(xb + (size_t)m * DM) + lane;
#pragma unroll
        for (int j = 0; j < 8; ++j) { v2u w; w.x = pk2(v[j].x, v[j].y); w.y = pk2(v[j].z, v[j].w); o8[64 * j] = w; }
        if (lane == 0) ssq[m] = s;
    }
}

typedef short bf16x8 __attribute__((ext_vector_type(8)));
constexpr int NCHUNK = NB * 4 * 32;
__device__ __forceinline__ void gla_prep_item(const Ctx& F, int item, const bf16* proj, const bf16* xb, const float* ssq, const bf16* wga, const float* w2, const float* gb, bf16* QT, bf16* KD, bf16* VT, bf16* PT, float* DEC) {
    const int b = item >> 6, n = (item >> 1) & 31, hp = item & 1, tid = F.tid, col = tid & 127, rg = tid >> 7, lane = F.lane, fr = lane & 15, fg = lane >> 4;
    const size_t m0 = (size_t)b * SEQ + n * 64;
    LAS float* GAl = (LAS float*)F.lds;
    LAS float* TOT = GAl + 1024;
    LAS bf16* Ql = (LAS bf16*)(F.lds + 6144);
    LAS bf16* Kl = (LAS bf16*)(F.lds + 23552);
    LAS bf16* Vl = (LAS bf16*)(F.lds + 40960);
    LAS float* GP = (LAS float*)(F.lds + 74752);
    v4u ql[2], kl[2], vl[4];
#define PREP_LOAD(h_) do { \
        _Pragma("unroll") for (int e = 0; e < 2; ++e) { const int idx = tid + 512 * e, row = idx >> 4, pc = idx & 15; \
            ql[e] = *(const v4u*)(proj + (m0 + row) * LDP + C_QA + (h_) * 128 + pc * 8); kl[e] = *(const v4u*)(proj + (m0 + row) * LDP + C_KA + (h_) * 128 + pc * 8); } \
        _Pragma("unroll") for (int e = 0; e < 4; ++e) { const int idx = tid + 512 * e, row = idx >> 5, pc = idx & 31; vl[e] = *(const v4u*)(proj + (m0 + row) * LDP + C_VA + (h_) * 256 + pc * 8); } } while (0)
    xcd_arrive(F.bar);
    float w2c[16]; float bias = gb[(2 * hp) * 128 + col];
#pragma unroll
    for (int j = 0; j < 16; ++j) w2c[j] = w2[j * 512 + (2 * hp) * 128 + col];
    {
        constexpr int XS = 520;
        LAS bf16* XB0 = (LAS bf16*)(F.lds + 8192); LAS bf16* XB1 = XB0 + 64 * XS;
        f32x4 gacc[4];
#pragma unroll
        for (int rt = 0; rt < 4; ++rt) gacc[rt] = (f32x4){0.f, 0.f, 0.f, 0.f};
        v4u xr[8], xq[8];
#define GA_LOAD(R_, sl_) do { _Pragma("unroll") for (int e = 0; e < 8; ++e) { const int idx = tid + 512 * e, row = idx >> 6, pc = idx & 63; R_[e] = *(const v4u*)(xb + (m0 + row) * DM + 512 * (sl_) + 8 * pc); } } while (0)
#define GA_STORE(R_, buf_) do { _Pragma("unroll") for (int e = 0; e < 8; ++e) { const int idx = tid + 512 * e, row = idx >> 6, pc = idx & 63; *(LAS v4u*)((buf_) + row * XS + 8 * pc) = R_[e]; } } while (0)
#define GA_COMP(buf_, sl_) do { _Pragma("unroll") for (int ks = 0; ks < 2; ++ks) { const int kl_ = 64 * F.wave + 32 * ks + 8 * fg; const bf16x8 B = *(const bf16x8*)(wga + fr * DM + 512 * (sl_) + kl_); \
            _Pragma("unroll") for (int rt = 0; rt < 4; ++rt) { const bf16x8 A = *(const LAS bf16x8*)((buf_) + (16 * rt + fr) * XS + kl_); gacc[rt] = __builtin_amdgcn_mfma_f32_16x16x32_bf16(A, B, gacc[rt], 0, 0, 0); } } } while (0)
        GA_LOAD(xr, 0); GA_LOAD(xq, 1); GA_STORE(xr, XB0); GA_LOAD(xr, 2); LDS_BARRIER();
        GA_COMP(XB0, 0); GA_STORE(xq, XB1); GA_LOAD(xq, 3); LDS_BARRIER();
        GA_COMP(XB1, 1); LDS_BARRIER();
        GA_STORE(xr, XB0); GA_STORE(xq, XB1);
        xcd_wait(F.bar);
        PREP_LOAD(2 * hp);
        GA_COMP(XB0, 2); GA_COMP(XB1, 3); LDS_BARRIER();
#undef GA_LOAD
#undef GA_STORE
#undef GA_COMP
#pragma unroll
        for (int rt = 0; rt < 4; ++rt)
#pragma unroll
            for (int e = 0; e < 4; ++e) GP[(F.wave * 64 + 16 * rt + 4 * fg + e) * 16 + fr] = gacc[rt][e];
        __syncthreads();
#pragma unroll
        for (int e = 0; e < 2; ++e) { const int idx = tid + 512 * e; float sum = 0.f;
#pragma unroll
            for (int w = 0; w < 8; ++w) sum += GP[w * 1024 + idx];
            GAl[idx] = sum * (1.0f / sqrtf(ssq[m0 + (idx >> 4)] * (1.0f / DM) + RMS_EPS)); }
    }
#pragma unroll 1
    for (int hh = 0; hh < 2; ++hh) {
    const int h = 2 * hp + hh, ch = (b * 4 + h) * 32 + n;
#pragma unroll
    for (int e = 0; e < 2; ++e) { const int idx = tid + 512 * e, row = idx >> 4, pc = idx & 15; *(LAS v4u*)(Ql + row * 136 + pc * 8) = ql[e]; *(LAS v4u*)(Kl + row * 136 + pc * 8) = kl[e]; }
#pragma unroll
    for (int e = 0; e < 4; ++e) { const int idx = tid + 512 * e, row = idx >> 5, pc = idx & 31; *(LAS v4u*)(Vl + row * 264 + pc * 8) = vl[e]; }
    if (hh == 0) PREP_LOAD(2 * hp + 1);
    __syncthreads();
    float pre[16]; float run = 0.f;
#pragma unroll
    for (int i = 0; i < 16; ++i) { const LAS f32x4* gr = (const LAS f32x4*)(GAl + (16 * rg + i) * 16); float gp = bias;
#pragma unroll
        for (int q = 0; q < 4; ++q) { const f32x4 gv = gr[q]; gp += gv.x * w2c[4 * q] + gv.y * w2c[4 * q + 1] + gv.z * w2c[4 * q + 2] + gv.w * w2c[4 * q + 3]; }
        run += (fminf(gp, 0.f) - __logf(1.0f + __expf(-fabsf(gp)))) * (1.0f / 16.0f); pre[i] = run; }
    TOT[rg * 128 + col] = run;
    if (hh == 0) { bias = gb[(2 * hp + 1) * 128 + col];
#pragma unroll
        for (int j = 0; j < 16; ++j) w2c[j] = w2[j * 512 + (2 * hp + 1) * 128 + col]; }
    LDS_BARRIER();
    float off = 0.f, blast = 0.f;
#pragma unroll
    for (int r4 = 0; r4 < 4; ++r4) { const float t = TOT[r4 * 128 + col]; if (r4 < rg) off += t; blast += t; }
    unsigned kdp[8];
#pragma unroll
    for (int i = 0; i < 16; i += 2) { float kd2[2];
#pragma unroll
        for (int u = 0; u < 2; ++u) { const int row = 16 * rg + i + u; const float bb = off + pre[i + u];
            const float qv = bf2f(Ql[row * 136 + col]), kv = bf2f(Kl[row * 136 + col]);
            Ql[row * 136 + col] = (bf16)f2bf(qv * 0.08838834764831845f * __expf(bb)); Kl[row * 136 + col] = (bf16)f2bf(kv * __expf(-bb)); kd2[u] = kv * __expf(blast - bb); }
        kdp[i >> 1] = pk2(kd2[0], kd2[1]); }
    { v4u* kdo = (v4u*)(KD + ((size_t)ch * 128 + col) * 64 + 16 * rg); kdo[0] = (v4u){kdp[0], kdp[1], kdp[2], kdp[3]}; kdo[1] = (v4u){kdp[4], kdp[5], kdp[6], kdp[7]}; }
    if (rg == 0) DEC[ch * 128 + col] = __expf(blast);
#pragma unroll
    for (int e = 0; e < 4; ++e) { const int idx = tid + 512 * e, dv = idx >> 3, oct = idx & 7; const LAS bf16* vp = Vl + (8 * oct) * 264 + dv;
        v4u o; o.x = (unsigned)vp[0] | ((unsigned)vp[264] << 16); o.y = (unsigned)vp[2 * 264] | ((unsigned)vp[3 * 264] << 16);
        o.z = (unsigned)vp[4 * 264] | ((unsigned)vp[5 * 264] << 16); o.w = (unsigned)vp[6 * 264] | ((unsigned)vp[7 * 264] << 16);
        *(v4u*)(VT + ((size_t)ch * 256 + dv) * 64 + 8 * oct) = o; }
    __syncthreads();
#pragma unroll
    for (int e = 0; e < 2; ++e) { const int idx = tid + 512 * e, row = idx >> 4, pc = idx & 15; *(v4u*)(QT + ((size_t)ch * 64 + row) * 128 + pc * 8) = *(const LAS v4u*)(Ql + row * 136 + pc * 8); }
    {   const int qt = F.wave >> 1;
#pragma unroll
        for (int jj = 0; jj < 2; ++jj) { const int jt = 2 * (F.wave & 1) + jj; f32x4 acc = {0.f, 0.f, 0.f, 0.f};
            if (jt <= qt) {
#pragma unroll
                for (int ks = 0; ks < 4; ++ks) { const bf16x8 A = *(const LAS bf16x8*)(Kl + (16 * jt + fr) * 136 + 32 * ks + 8 * fg), B = *(const LAS bf16x8*)(Ql + (16 * qt + fr) * 136 + 32 * ks + 8 * fg);
                    acc = __builtin_amdgcn_mfma_f32_16x16x32_bf16(A, B, acc, 0, 0, 0); } }
            const int iq = 16 * qt + fr, j0 = 16 * jt + 4 * fg;
            v2u w; w.x = pk2(j0 <= iq ? acc[0] : 0.f, j0 + 1 <= iq ? acc[1] : 0.f); w.y = pk2(j0 + 2 <= iq ? acc[2] : 0.f, j0 + 3 <= iq ? acc[3] : 0.f);
            *(v2u*)(PT + ((size_t)ch * 64 + iq) * 64 + j0) = w; } }
    __syncthreads();
    }
#undef PREP_LOAD
}
__device__ __forceinline__ void st16_wt(void* p, v4u v) { asm volatile("global_store_dwordx4 %0, %1, off sc1\n\ts_nop 2" :: "v"(p), "v"(v) : "memory"); }
constexpr int SC_ROW = 72, SC_KD_B = 128 * SC_ROW * 2, SC_VT_B = 128 * SC_ROW * 2, SC_SLOT = SC_KD_B + SC_VT_B + 512;
struct ScanRegs { v4u kd[2], vt[2], dc; };
__device__ __forceinline__ void gla_scan_block(const Ctx& F, int task, const bf16* KD, const bf16* VT, const float* DEC, bf16* SN) {
    const int bh = task >> 1, dvh = task & 1, tid = F.tid, lane = F.lane, fr = lane & 15, fg = lane >> 4, kh = F.wave >> 2, dq = F.wave & 3;
    f32x4 S[4][2];
#pragma unroll
    for (int kt = 0; kt < 4; ++kt)
#pragma unroll
        for (int dt = 0; dt < 2; ++dt) S[kt][dt] = (f32x4){0.f, 0.f, 0.f, 0.f};
#define SC_LOAD(R_, ch_) do { const int c_ = (ch_); \
        _Pragma("unroll") for (int e = 0; e < 2; ++e) R_.kd[e] = *(const v4u*)(KD + (size_t)c_ * 128 * 64 + (size_t)(tid + 512 * e) * 8); \
        _Pragma("unroll") for (int e = 0; e < 2; ++e) R_.vt[e] = *(const v4u*)(VT + ((size_t)c_ * 256 + 128 * dvh) * 64 + (size_t)(tid + 512 * e) * 8); \
        if (tid < 32) R_.dc = *(const v4u*)(DEC + (size_t)c_ * 128 + tid * 4); } while (0)
#define SC_STORE(R_, slot_) do { LAS unsigned char* sl_ = F.lds + (slot_) * SC_SLOT; \
        _Pragma("unroll") for (int e = 0; e < 2; ++e) { const int idx = tid + 512 * e; *(LAS v4u*)(sl_ + ((idx >> 3) * SC_ROW + (idx & 7) * 8) * 2) = R_.kd[e]; } \
        _Pragma("unroll") for (int e = 0; e < 2; ++e) { const int idx = tid + 512 * e; *(LAS v4u*)(sl_ + SC_KD_B + ((idx >> 3) * SC_ROW + (idx & 7) * 8) * 2) = R_.vt[e]; } \
        if (tid < 32) *(LAS v4u*)(sl_ + SC_KD_B + SC_VT_B + tid * 16) = R_.dc; } while (0)
#define SC_STEP(n_, RS_, RL_) do { const int ch = bh * 32 + (n_); \
          \
        _Pragma("unroll") for (int dt = 0; dt < 2; ++dt) _Pragma("unroll") for (int j = 0; j < 2; ++j) { v4u wv; wv.x = pk2(S[2 * j][dt][0], S[2 * j][dt][1]); wv.y = pk2(S[2 * j][dt][2], S[2 * j][dt][3]); \
            wv.z = pk2(S[2 * j + 1][dt][0], S[2 * j + 1][dt][1]); wv.w = pk2(S[2 * j + 1][dt][2], S[2 * j + 1][dt][3]); \
            st16_wt(SN + (((size_t)ch * 4 + 2 * kh + j) * 256 + 128 * dvh + 32 * dq + 16 * dt + fr) * 32 + 8 * fg, wv); } \
        if ((n_) < 31) { \
            const LAS unsigned char* sl = F.lds + ((n_) & 1) * SC_SLOT; \
            bf16x8 Bf[2][2]; \
            _Pragma("unroll") for (int dt = 0; dt < 2; ++dt) _Pragma("unroll") for (int ks = 0; ks < 2; ++ks) Bf[dt][ks] = *(const LAS bf16x8*)(sl + SC_KD_B + ((32 * dq + 16 * dt + fr) * SC_ROW + 32 * ks + 8 * fg) * 2); \
            _Pragma("unroll") for (int kt = 0; kt < 4; ++kt) {   \
                const f32x4 dd = *(const LAS f32x4*)(sl + SC_KD_B + SC_VT_B + (64 * kh + 32 * (kt >> 1) + 8 * fg + 4 * (kt & 1)) * 4); \
                const int kr = 64 * kh + 32 * (kt >> 1) + 8 * (fr >> 2) + 4 * (kt & 1) + (fr & 3); \
                const bf16x8 A0 = *(const LAS bf16x8*)(sl + (kr * SC_ROW + 8 * fg) * 2), A1 = *(const LAS bf16x8*)(sl + (kr * SC_ROW + 32 + 8 * fg) * 2); \
                _Pragma("unroll") for (int dt = 0; dt < 2; ++dt) { f32x4 sv = S[kt][dt] * dd; sv = __builtin_amdgcn_mfma_f32_16x16x32_bf16(A0, Bf[dt][0], sv, 0, 0, 0); \
                    S[kt][dt] = __builtin_amdgcn_mfma_f32_16x16x32_bf16(A1, Bf[dt][1], sv, 0, 0, 0); } } \
              \
            SC_STORE(RS_, ((n_) + 1) & 1); \
            SC_LOAD(RS_, bh * 32 + ((n_) + 3 < 31 ? (n_) + 3 : 30)); \
            LDS_BARRIER(); } } while (0)
    ScanRegs RA, RB;
    SC_LOAD(RA, bh * 32); SC_STORE(RA, 0);
    SC_LOAD(RA, bh * 32 + 1); SC_LOAD(RB, bh * 32 + 2);
    LDS_BARRIER();
#pragma unroll 1
    for (int n = 0; n < 32; n += 2) { SC_STEP(n, RA, RB); SC_STEP(n + 1, RB, RA); }
#undef SC_LOAD
#undef SC_STORE
#undef SC_STEP
    __syncthreads();
}
template <bool SPLIT> __device__ __forceinline__ void gla_out_chunk(const Ctx& F, int ch, const bf16* proj, const bf16* QT, const bf16* VT, const bf16* PT, const bf16* SN, const float* gon, bf16* mix) {
    const int bh = ch >> 5, n = ch & 31, b = bh >> 2, h = bh & 3, tid = F.tid, lane = F.lane, fr = lane & 15, fg = lane >> 4, qt = F.wave >> 1, dvh = F.wave & 1, iq = 16 * qt + fr;
    const size_t m = (size_t)b * SEQ + n * 64 + iq;
    LAS unsigned char* SNl = F.lds;
    LAS bf16* VTl = (LAS bf16*)(F.lds + 69632);
    LAS bf16* QTl = (LAS bf16*)(F.lds + 106496);
    LAS bf16* PTl = (LAS bf16*)(F.lds + 123904);
    LAS float* red = (LAS float*)(F.lds + 133120);
    v4u sn[8];
    {   v4u vt[4], q2[2], p1;
        if (!SPLIT) {
#pragma unroll
            for (int e = 0; e < 8; ++e) { const int idx = tid + 512 * e; sn[e] = *(const v4u*)(SN + (size_t)ch * 256 * 128 + (size_t)idx * 8); } }
#pragma unroll
        for (int e = 0; e < 4; ++e) { const int idx = tid + 512 * e; vt[e] = *(const v4u*)(VT + (size_t)ch * 256 * 64 + (size_t)idx * 8); }
#pragma unroll
        for (int e = 0; e < 2; ++e) { const int idx = tid + 512 * e; q2[e] = *(const v4u*)(QT + (size_t)ch * 64 * 128 + (size_t)idx * 8); }
        p1 = *(const v4u*)(PT + (size_t)ch * 64 * 64 + (size_t)tid * 8);
        if (!SPLIT) {
#pragma unroll
            for (int e = 0; e < 8; ++e) { const int idx = tid + 512 * e, kb = idx >> 10, dv = (idx >> 2) & 255; *(LAS v4u*)(SNl + kb * 17408 + dv * 64 + (dv >> 2) * 16 + (idx & 3) * 16) = sn[e]; } }
#pragma unroll
        for (int e = 0; e < 4; ++e) { const int idx = tid + 512 * e; *(LAS v4u*)(VTl + (idx >> 3) * 72 + (idx & 7) * 8) = vt[e]; }
#pragma unroll
        for (int e = 0; e < 2; ++e) { const int idx = tid + 512 * e; *(LAS v4u*)(QTl + (idx >> 4) * 136 + (idx & 15) * 8) = q2[e]; }
        *(LAS v4u*)(PTl + (tid >> 3) * 72 + (tid & 7) * 8) = p1;
    }
    v2u rw[8];
#pragma unroll
    for (int t = 0; t < 8; ++t) rw[t] = *(const v2u*)(proj + m * LDP + C_RA + h * 256 + 128 * dvh + 16 * t + 4 * fg);
    if (SPLIT) { xcd_wait(F.bar);
#pragma unroll
        for (int e = 0; e < 8; ++e) { const int idx = tid + 512 * e; sn[e] = *(const v4u*)(SN + (size_t)ch * 256 * 128 + (size_t)idx * 8); } }
    else __syncthreads();
    f32x4 acc[8];
#pragma unroll
    for (int t = 0; t < 8; ++t) acc[t] = (f32x4){0.f, 0.f, 0.f, 0.f};
#pragma unroll
    for (int ks = 0; ks < 2; ++ks) if (32 * ks <= 16 * qt + 15) { const bf16x8 Bp = *(const LAS bf16x8*)(PTl + iq * 72 + 32 * ks + 8 * fg);
#pragma unroll
        for (int t = 0; t < 8; ++t) { const bf16x8 A = *(const LAS bf16x8*)(VTl + (128 * dvh + 16 * t + fr) * 72 + 32 * ks + 8 * fg); acc[t] = __builtin_amdgcn_mfma_f32_16x16x32_bf16(A, Bp, acc[t], 0, 0, 0); } }
    if (SPLIT) {
#pragma unroll
        for (int e = 0; e < 8; ++e) { const int idx = tid + 512 * e, kb = idx >> 10, dv = (idx >> 2) & 255; *(LAS v4u*)(SNl + kb * 17408 + dv * 64 + (dv >> 2) * 16 + (idx & 3) * 16) = sn[e]; }
        __syncthreads(); }
    if (n > 0) {
#pragma unroll
        for (int ks = 0; ks < 4; ++ks) { const bf16x8 Bq = *(const LAS bf16x8*)(QTl + iq * 136 + 32 * ks + 8 * fg);
#pragma unroll
            for (int t = 0; t < 8; ++t) { const int dv = 128 * dvh + 16 * t + fr; const bf16x8 A = *(const LAS bf16x8*)(SNl + ks * 17408 + dv * 64 + (dv >> 2) * 16 + fg * 16); acc[t] = __builtin_amdgcn_mfma_f32_16x16x32_bf16(A, Bq, acc[t], 0, 0, 0); } } }
    float ss = 0.f;
#pragma unroll
    for (int t = 0; t < 8; ++t) ss += (acc[t][0] * acc[t][0] + acc[t][1] * acc[t][1]) + (acc[t][2] * acc[t][2] + acc[t][3] * acc[t][3]);
    ss += __shfl_xor(ss, 16); ss += __shfl_xor(ss, 32);
    if (fg == 0) red[F.wave * 16 + fr] = ss;
    __syncthreads();
    const float tot = red[(2 * qt) * 16 + fr] + red[(2 * qt + 1) * 16 + fr];
    const float rstd = 1.0f / sqrtf(tot * (1.0f / 256.0f) + RMS_EPS);
#pragma unroll
    for (int t = 0; t < 8; ++t) { const int dv0 = 128 * dvh + 16 * t + 4 * fg; const f32x4 g4 = *(const f32x4*)(gon + dv0);
        const float r0 = bflo(rw[t].x), r1 = bfhi(rw[t].x), r2 = bflo(rw[t].y), r3 = bfhi(rw[t].y);
        const float y0 = acc[t][0] * rstd * g4.x * (r0 / (1.0f + __expf(-r0))), y1 = acc[t][1] * rstd * g4.y * (r1 / (1.0f + __expf(-r1)));
        const float y2 = acc[t][2] * rstd * g4.z * (r2 / (1.0f + __expf(-r2))), y3 = acc[t][3] * rstd * g4.w * (r3 / (1.0f + __expf(-r3)));
        v2u w; w.x = pk2(y0, y1); w.y = pk2(y2, y3); *(v2u*)(mix + m * DM + h * 256 + dv0) = w; }
    __syncthreads();
}

__device__ __forceinline__ void gla_out_pair(const Ctx& F, int chA, int chB, const bf16* proj, const bf16* QT, const bf16* VT, const bf16* PT, const bf16* SN, const float* gon, bf16* mix) {
    const int tid = F.tid, lane = F.lane, fr = lane & 15, fg = lane >> 4, qt = F.wave >> 1, dvh = F.wave & 1, iq = 16 * qt + fr;
    LAS unsigned char* SNl = F.lds; LAS bf16* VTl = (LAS bf16*)(F.lds + 69632); LAS bf16* QTl = (LAS bf16*)(F.lds + 106496); LAS bf16* PTl = (LAS bf16*)(F.lds + 123904); LAS float* red = (LAS float*)(F.lds + 133120);
    const int hA = (chA >> 5) & 3, nA = chA & 31, hB = (chB >> 5) & 3, nB = chB & 31;
    const size_t mA = (size_t)(chA >> 7) * SEQ + nA * 64 + iq, mB = (size_t)(chB >> 7) * SEQ + nB * 64 + iq;
    v4u sn[8], vt[4], q2[2], p1; v2u rw[8];
#define GO_LOAD_VQP(ch_) do { _Pragma("unroll") for (int e = 0; e < 4; ++e) { const int idx = tid + 512 * e; vt[e] = *(const v4u*)(VT + (size_t)(ch_) * 256 * 64 + (size_t)idx * 8); } \
        _Pragma("unroll") for (int e = 0; e < 2; ++e) { const int idx = tid + 512 * e; q2[e] = *(const v4u*)(QT + (size_t)(ch_) * 64 * 128 + (size_t)idx * 8); } \
        p1 = *(const v4u*)(PT + (size_t)(ch_) * 64 * 64 + (size_t)tid * 8); } while (0)
#define GO_STORE_VQP() do { _Pragma("unroll") for (int e = 0; e < 4; ++e) { const int idx = tid + 512 * e; *(LAS v4u*)(VTl + (idx >> 3) * 72 + (idx & 7) * 8) = vt[e]; } \
        _Pragma("unroll") for (int e = 0; e < 2; ++e) { const int idx = tid + 512 * e; *(LAS v4u*)(QTl + (idx >> 4) * 136 + (idx & 15) * 8) = q2[e]; } \
        *(LAS v4u*)(PTl + (tid >> 3) * 72 + (tid & 7) * 8) = p1; } while (0)
#define GO_LOAD_SN(ch_, e0_, e1_) do { _Pragma("unroll") for (int e = (e0_); e < (e1_); ++e) { const int idx = tid + 512 * e; sn[e] = *(const v4u*)(SN + (size_t)(ch_) * 256 * 128 + (size_t)idx * 8); } } while (0)
#define GO_STORE_SN() do { _Pragma("unroll") for (int e = 0; e < 8; ++e) { const int idx = tid + 512 * e, kb = idx >> 10, dv = (idx >> 2) & 255; *(LAS v4u*)(SNl + kb * 17408 + dv * 64 + (dv >> 2) * 16 + (idx & 3) * 16) = sn[e]; } } while (0)
#define GO_LOAD_RW(m_, h_) do { _Pragma("unroll") for (int t = 0; t < 8; ++t) rw[t] = *(const v2u*)(proj + (m_) * LDP + C_RA + (h_) * 256 + 128 * dvh + 16 * t + 4 * fg); } while (0)
#define GO_INTRA() do { _Pragma("unroll") for (int ks = 0; ks < 2; ++ks) if (32 * ks <= 16 * qt + 15) { const bf16x8 Bp = *(const LAS bf16x8*)(PTl + iq * 72 + 32 * ks + 8 * fg); \
        _Pragma("unroll") for (int t = 0; t < 8; ++t) { const bf16x8 A = *(const LAS bf16x8*)(VTl + (128 * dvh + 16 * t + fr) * 72 + 32 * ks + 8 * fg); acc[t] = __builtin_amdgcn_mfma_f32_16x16x32_bf16(A, Bp, acc[t], 0, 0, 0); } } } while (0)
#define GO_INTER_KS(ks_) do { const bf16x8 Bq = *(const LAS bf16x8*)(QTl + iq * 136 + 32 * (ks_) + 8 * fg); \
        _Pragma("unroll") for (int t = 0; t < 8; ++t) { const int dv = 128 * dvh + 16 * t + fr; const bf16x8 A = *(const LAS bf16x8*)(SNl + (ks_) * 17408 + dv * 64 + (dv >> 2) * 16 + fg * 16); acc[t] = __builtin_amdgcn_mfma_f32_16x16x32_bf16(A, Bq, acc[t], 0, 0, 0); } } while (0)
#define GO_NORM_SUM() do { float ss = 0.f; _Pragma("unroll") for (int t = 0; t < 8; ++t) ss += (acc[t][0] * acc[t][0] + acc[t][1] * acc[t][1]) + (acc[t][2] * acc[t][2] + acc[t][3] * acc[t][3]); \
        ss += __shfl_xor(ss, 16); ss += __shfl_xor(ss, 32); if (fg == 0) red[F.wave * 16 + fr] = ss; } while (0)
#define GO_EPILOGUE(m_, h_) do { const float tot = red[(2 * qt) * 16 + fr] + red[(2 * qt + 1) * 16 + fr]; const float rstd = 1.0f / sqrtf(tot * (1.0f / 256.0f) + RMS_EPS); \
        _Pragma("unroll") for (int t = 0; t < 8; ++t) { const int dv0 = 128 * dvh + 16 * t + 4 * fg; const f32x4 g4 = *(const f32x4*)(gon + dv0); \
            const float r0 = bflo(rw[t].x), r1 = bfhi(rw[t].x), r2 = bflo(rw[t].y), r3 = bfhi(rw[t].y); \
            const float y0 = acc[t][0] * rstd * g4.x * (r0 / (1.0f + __expf(-r0))), y1 = acc[t][1] * rstd * g4.y * (r1 / (1.0f + __expf(-r1))); \
            const float y2 = acc[t][2] * rstd * g4.z * (r2 / (1.0f + __expf(-r2))), y3 = acc[t][3] * rstd * g4.w * (r3 / (1.0f + __expf(-r3))); \
            v2u w; w.x = pk2(y0, y1); w.y = pk2(y2, y3); *(v2u*)(mix + (m_) * DM + (h_) * 256 + dv0) = w; } } while (0)
    f32x4 acc[8];
    GO_LOAD_VQP(chA); GO_STORE_VQP(); GO_LOAD_RW(mA, hA);
    xcd_wait(F.bar);
    GO_LOAD_SN(chA, 0, 8);
#pragma unroll
    for (int t = 0; t < 8; ++t) acc[t] = (f32x4){0.f, 0.f, 0.f, 0.f};
    GO_INTRA();
    GO_STORE_SN();
    GO_LOAD_VQP(chB);
    __syncthreads();
#pragma unroll
    for (int ks = 0; ks < 4; ++ks) { GO_LOAD_SN(chB, 2 * ks, 2 * ks + 2); __builtin_amdgcn_sched_barrier(0); if (nA > 0) GO_INTER_KS(ks); }
    GO_NORM_SUM();
    __syncthreads();
    GO_EPILOGUE(mA, hA);
    GO_LOAD_RW(mB, hB);
    __syncthreads();
    GO_STORE_SN(); GO_STORE_VQP();
    __syncthreads();
#pragma unroll
    for (int t = 0; t < 8; ++t) acc[t] = (f32x4){0.f, 0.f, 0.f, 0.f};
    GO_INTRA();
    if (nB > 0) {
#pragma unroll
        for (int ks = 0; ks < 4; ++ks) GO_INTER_KS(ks); }
    GO_NORM_SUM();
    __syncthreads();
    GO_EPILOGUE(mB, hB);
    __syncthreads();
#undef GO_LOAD_VQP
#undef GO_STORE_VQP
#undef GO_LOAD_SN
#undef GO_STORE_SN
#undef GO_LOAD_RW
#undef GO_INTRA
#undef GO_INTER_KS
#undef GO_NORM_SUM
#undef GO_EPILOGUE
}

typedef short s16x4 __attribute__((ext_vector_type(4)));
constexpr int AT_KROW = 136, AT_VROW = 144;
constexpr int AT_V_OFF = 256 * AT_KROW * 2, AT_TB_OFF = AT_V_OFF + 256 * AT_VROW * 2;
constexpr float LOG2E = 1.4426950408889634f;
struct AttnUnit { int b, h, br, cls, pb; };
__device__ const unsigned char kAttnPlan[28][8] = {
 {1,50,99,148,35,90,160,255},
 {2,51,100,149,36,91,164,255},
 {3,52,101,150,37,92,168,255},
 {4,53,102,151,38,93,172,255},
 {5,54,103,152,39,94,176,255},
 {6,55,104,153,40,95,177,255},
 {7,56,105,154,41,96,178,255},
 {8,57,106,155,42,112,179,255},
 {9,58,107,156,43,116,180,255},
 {10,59,108,157,44,120,181,255},
 {11,60,109,158,45,124,182,255},
 {12,61,110,159,46,128,183,255},
 {13,62,111,161,47,129,184,255},
 {14,63,113,162,48,130,185,255},
 {15,65,114,163,64,131,186,255},
 {17,66,115,165,68,132,187,255},
 {18,67,117,166,72,133,188,255},
 {19,69,118,167,76,134,189,255},
 {21,70,119,169,80,135,190,255},
 {22,71,121,170,81,136,191,255},
 {23,73,122,171,82,137,255,255},
 {25,74,123,173,83,138,255,255},
 {26,75,125,174,84,139,255,255},
 {27,77,126,175,85,140,255,255},
 {29,78,127,0,28,86,141,255},
 {30,79,145,16,32,87,142,255},
 {31,97,146,20,33,88,143,255},
 {49,98,147,24,34,89,144,255}};
__device__ __forceinline__ AttnUnit attn_unit_of(int bid, int it) {
    const int q = kAttnPlan[(bid - 32) >> 3][it], bh = 8 * (q / 48) + (bid & 7), rem = q % 48, br = rem >> 4, uu = rem & 15;
    AttnUnit u; u.b = bh >> 3; u.h = bh & 7; u.br = br; u.cls = br == 0 ? 0 : (br == 1 ? uu >> 2 : uu); u.pb = br == 0 ? uu : (br == 1 ? (uu & 3) : 0); return u;
}
__device__ __forceinline__ void attn_phase(const Ctx& F, const bf16* proj, const float* rel_bias, const float* mb  , bf16* OP0, bf16* OP1, bf16* OP2, float* LP) {
    const int tid = F.tid, lane = F.lane, fr = lane & 15, fg = lane >> 4, w = F.wave;
    LAS bf16* Kl = (LAS bf16*)F.lds; LAS bf16* Vl = (LAS bf16*)(F.lds + AT_V_OFF); LAS float* tb = (LAS float*)(F.lds + AT_TB_OFF);
    v4u kreg[8], vreg[8]; bf16x8 Qn[4];
#define AT_LOAD(U_) do { const int sh_ = 2 * (U_).br; const bf16* pb_ = proj + ((size_t)(U_).h * T + (size_t)(U_).b * SEQ) * 128;     \
        _Pragma("unroll") for (int e = 0; e < 8; ++e) { if (e < 4 && (U_).pb == 0) continue;     \
            const int idx = tid + 512 * e, row = idx >> 4, pc = idx & 15; const int pos = 128 * ((U_).pb - 1) + row; \
            const bf16* rp = pb_ + (size_t)((pos << sh_) + (U_).cls) * 128 + 8 * pc; kreg[e] = *(const v4u*)(rp + (size_t)8 * T * 128); vreg[e] = *(const v4u*)(rp + (size_t)16 * T * 128); } \
        { const int tq_ = ((128 * (U_).pb + 16 * w + fr) << sh_) + (U_).cls; \
          _Pragma("unroll") for (int ks = 0; ks < 4; ++ks) Qn[ks] = *(const bf16x8*)(pb_ + (size_t)tq_ * 128 + 32 * ks + 8 * fg); } } while (0)
#define AT_LOAD_PART(U_, p_) do { const int sh_ = 2 * (U_).br; const bf16* pb_ = proj + ((size_t)(U_).h * T + (size_t)(U_).b * SEQ) * 128; \
        if ((p_) < 4) { _Pragma("unroll") for (int e = 2 * (p_); e < 2 * (p_) + 2; ++e) { if (e < 4 && (U_).pb == 0) continue; \
            const int idx = tid + 512 * e, row = idx >> 4, pc = idx & 15; const int pos = 128 * ((U_).pb - 1) + row; \
            const bf16* rp = pb_ + (size_t)((pos << sh_) + (U_).cls) * 128 + 8 * pc; kreg[e] = *(const v4u*)(rp + (size_t)8 * T * 128); vreg[e] = *(const v4u*)(rp + (size_t)16 * T * 128); } } \
        else { const int tq_ = ((128 * (U_).pb + 16 * w + fr) << sh_) + (U_).cls; \
          _Pragma("unroll") for (int ks = 0; ks < 4; ++ks) Qn[ks] = *(const bf16x8*)(pb_ + (size_t)tq_ * 128 + 32 * ks + 8 * fg); } } while (0)
#define AT_STORE(U_) do { \
        _Pragma("unroll") for (int e = 0; e < 8; ++e) { if (e < 4 && (U_).pb == 0) continue; \
            const int idx = tid + 512 * e, row = idx >> 4, pc = idx & 15; *(LAS v4u*)(Kl + row * AT_KROW + 8 * pc) = kreg[e]; *(LAS v4u*)(Vl + row * AT_VROW + 8 * pc) = vreg[e]; } \
        } while (0)
    int nun = 0; for (int i = 0; i < 8; ++i) nun += kAttnPlan[(F.bid - 32) >> 3][i] != 255 ? 1 : 0;
    AttnUnit U = attn_unit_of(F.bid, 0);
    AT_LOAD(U);
    if (tid < 396) { const int hh = F.bid & 7, br_ = tid / 132, e_ = tid % 132;
        const float M = mb[hh]; float v = -INFINITY;
        if (e_ >= 1 && e_ <= 129) v = (rel_bias[kBucket[br_][e_ - 1] * 8 + hh] - M) * LOG2E;
        tb[tid] = v; }
    AT_STORE(U);
    __syncthreads();
    const unsigned tr_off = (unsigned)(((fr >> 2) + 4 * fg) * AT_VROW + 4 * (fr & 3)) * 2u;
#pragma unroll 1
    for (int it = 0; it < nun; ++it) {
        bf16x8 Qf[4];
#pragma unroll
        for (int ks = 0; ks < 4; ++ks) Qf[ks] = Qn[ks];
        const AttnUnit Un = attn_unit_of(F.bid, it + 1 < nun ? it + 1 : it);
        const bool more = it + 1 < nun;
        f32x4 O[8];
#pragma unroll
        for (int t = 0; t < 8; ++t) O[t] = (f32x4){0.f, 0.f, 0.f, 0.f};
        float lsum = 0.f;
        int a_lo = w >> 1; const int a_hi = (w >> 1) + 4; if (U.pb == 0 && a_lo < 4) a_lo = 4;
        const LAS float* tbu = tb + 132 * U.br;
        const int relc = 129 + 16 * w + fr - 4 * fg;
#pragma unroll
        for (int ai_ = 0; ai_ < 5; ++ai_) { if (more) AT_LOAD_PART(Un, ai_); __builtin_amdgcn_sched_barrier(0); const int a = (w >> 1) + ai_; if (a < a_lo) continue;
            f32x4 sa = {0.f, 0.f, 0.f, 0.f}, sb = {0.f, 0.f, 0.f, 0.f};
            const LAS bf16* kp = Kl + (32 * a + fr) * AT_KROW + 8 * fg;
#pragma unroll
            for (int ks = 0; ks < 4; ++ks) { const bf16x8 Ka = *(const LAS bf16x8*)(kp + 32 * ks), Kb = *(const LAS bf16x8*)(kp + 16 * AT_KROW + 32 * ks);
                sa = __builtin_amdgcn_mfma_f32_16x16x32_bf16(Ka, Qf[ks], sa, 0, 0, 0); sb = __builtin_amdgcn_mfma_f32_16x16x32_bf16(Kb, Qf[ks], sb, 0, 0, 0); }
            const int ia = relc - 32 * a; float pa_[4], pb_[4];
#pragma unroll
            for (int e = 0; e < 4; ++e) { int xa = ia - e, xb = ia - 16 - e; xa = xa < 0 ? 0 : (xa > 130 ? 130 : xa); xb = xb < 0 ? 0 : (xb > 130 ? 130 : xb);
                pa_[e] = __builtin_amdgcn_exp2f(sa[e] + tbu[xa]); pb_[e] = __builtin_amdgcn_exp2f(sb[e] + tbu[xb]); }
            lsum += ((pa_[0] + pa_[1]) + (pa_[2] + pa_[3])) + ((pb_[0] + pb_[1]) + (pb_[2] + pb_[3]));
            v4u pw; pw.x = pk2(pa_[0], pa_[1]); pw.y = pk2(pa_[2], pa_[3]); pw.z = pk2(pb_[0], pb_[1]); pw.w = pk2(pb_[2], pb_[3]);
            const bf16x8 Pf = __builtin_bit_cast(bf16x8, pw);
            LAS unsigned char* vb = (LAS unsigned char*)Vl + (32 * a) * (AT_VROW * 2) + tr_off;
#pragma unroll
            for (int t = 0; t < 8; ++t) {
                const s16x4 va = __builtin_bit_cast(s16x4, __builtin_amdgcn_ds_read_tr16_b64_v4i16((LAS s16x4*)(vb + 32 * t)));
                const s16x4 vb2 = __builtin_bit_cast(s16x4, __builtin_amdgcn_ds_read_tr16_b64_v4i16((LAS s16x4*)(vb + 16 * AT_VROW * 2 + 32 * t)));
                const bf16x8 Vf = {va[0], va[1], va[2], va[3], vb2[0], vb2[1], vb2[2], vb2[3]};
                O[t] = __builtin_amdgcn_mfma_f32_16x16x32_bf16(Vf, Pf, O[t], 0, 0, 0); }
        }
        lsum += __shfl_xor(lsum, 16); lsum += __shfl_xor(lsum, 32);
        {   const float inv = 1.0f / lsum; const int tq = ((128 * U.pb + 16 * w + fr) << (2 * U.br)) + U.cls; const size_t m = (size_t)U.b * SEQ + tq;
            bf16* op = (U.br == 0 ? OP0 : (U.br == 1 ? OP1 : OP2)) + m * 1024 + U.h * 128 + 4 * fg;
#pragma unroll
            for (int t = 0; t < 8; ++t) { v2u wv; wv.x = pk2(O[t][0] * inv, O[t][1] * inv); wv.y = pk2(O[t][2] * inv, O[t][3] * inv); *(v2u*)(op + 16 * t) = wv; }
            if (fg == 0) LP[((size_t)U.br * T + m) * 8 + U.h] = lsum; }
        LDS_BARRIER();
        if (it + 1 < nun) { AT_STORE(Un); LDS_BARRIER(); }
        U = Un;
    }
#undef AT_LOAD
#undef AT_LOAD_PART
#undef AT_STORE
}
__device__ __forceinline__ void attn_combine(const Ctx& F, const bf16* OP0, const bf16* OP1, const bf16* OP2, const float* LP, bf16* mix) {
    for (int i = F.bid * NTHR + F.tid; i < T * 128; i += F.G * NTHR) { const int m = i >> 7, pc = i & 127, h = pc >> 4;
        const float l0 = LP[(size_t)m * 8 + h], l1 = LP[((size_t)T + m) * 8 + h], l2 = LP[((size_t)2 * T + m) * 8 + h]; const float inv = 1.0f / (l0 + l1 + l2);
        const float w0 = l0 * inv, w1 = l1 * inv, w2 = l2 * inv;
        const v4u a = *(const v4u*)(OP0 + (size_t)m * 1024 + 8 * pc), b = *(const v4u*)(OP1 + (size_t)m * 1024 + 8 * pc), c = *(const v4u*)(OP2 + (size_t)m * 1024 + 8 * pc);
        v4u o;
        o.x = pk2(w0 * bflo(a.x) + w1 * bflo(b.x) + w2 * bflo(c.x), w0 * bfhi(a.x) + w1 * bfhi(b.x) + w2 * bfhi(c.x));
        o.y = pk2(w0 * bflo(a.y) + w1 * bflo(b.y) + w2 * bflo(c.y), w0 * bfhi(a.y) + w1 * bfhi(b.y) + w2 * bfhi(c.y));
        o.z = pk2(w0 * bflo(a.z) + w1 * bflo(b.z) + w2 * bflo(c.z), w0 * bfhi(a.z) + w1 * bfhi(b.z) + w2 * bfhi(c.z));
        o.w = pk2(w0 * bflo(a.w) + w1 * bflo(b.w) + w2 * bflo(c.w), w0 * bfhi(a.w) + w1 * bfhi(b.w) + w2 * bfhi(c.w));
        *(v4u*)(mix + (size_t)m * DM + 1024 + 8 * pc) = o; }
}

constexpr int NPHASE = 2 + 7 * DEPTH;
struct Args { const float* in[14]; float* out; unsigned char* ws; int ph_lo, ph_hi; };
#define PH_IN(k) (lo <= (k) && (k) < hi)
#define PH_END(k) do { if (PH_IN((k) + 1)) { if ((k) < 0) grid.sync(); else xcd_barrier(F.bar); } } while (0)
template <int L> __device__ __forceinline__ void layer_phases(const Ctx& F, const int lo, const int hi, cg::grid_group& grid) {
    constexpr int P0 = 2 + 7 * L;
    bf16* QT = (bf16*)(F.ws + WS_QT); bf16* KD = (bf16*)(F.ws + WS_KD); bf16* VT = (bf16*)(F.ws + WS_VT); bf16* PT = (bf16*)(F.ws + WS_PT); float* DEC = (float*)(F.ws + WS_DEC); bf16* SN = (bf16*)(F.ws + WS_SN);
    bf16* XB = (bf16*)(F.ws + WS_XB); bf16* PROJ = (bf16*)(F.ws + WS_PROJ); bf16* ATT = PROJ + (size_t)T * LDP;     bf16* HMID = (bf16*)(F.ws + WS_HMID); bf16* MIX = (bf16*)(F.ws + WS_MIX);
    float* SSQ = (float*)(F.ws + WS_SSQ);
    if (PH_IN(P0 + 0)) {
        pg8::Gemm g{XB, (const bf16*)(F.ws + WS_WIN + L * SZ_WIN), T, NPROJ, DM}; pg8::StaticOrder S; S.init(T, NPROJ, F.G, F.bid);
        pg8::EpiBf16<0> E{PROJ, LDP, SSQ + (2 * L) * T, C_QB / 256, C_KB / 256, C_VB / 256, F.qn_g + L * 128, F.kn_g + L * 128, 0.08838834764831845f * 1.4426950408889634f, (LAS float*)(F.lds + 131072), ATT, T};
        pg8::gemm_phase<pg8::EpiBf16<0>, pg8::StaticOrder, true, true>(F.lds, g, S, E); }
    if (PH_IN(P0 + 1)) {
        { const int it = (((F.bid >> 4) * 8 + (F.bid & 7)) << 1) | ((F.bid >> 3) & 1);
          gla_prep_item(F, it, PROJ, XB, SSQ + (2 * L) * T, (const bf16*)(F.ws + WS_WGA) + L * 16 * DM, F.gate_w2 + L * 16 * 512, F.gate_b + L * 512, QT, KD, VT, PT, DEC); }
        xcd_arrive(F.bar);
        bf16* OP0 = (bf16*)F.out; bf16* OP1 = OP0 + (size_t)T * 1024; bf16* OP2 = (bf16*)(F.ws + WS_OP2); float* LP = (float*)(F.ws + WS_LP);
        if (F.bid < 32) { xcd_wait(F.bar); gla_scan_block(F, F.bid, KD, VT, DEC, SN); }
        else { attn_phase(F, ATT, F.rel_bias, (const float*)(F.ws + WS_MB) + L * 8, OP0, OP1, OP2, LP); xcd_wait(F.bar); }

        xcd_arrive(F.bar);
        gla_out_pair(F, F.bid, F.bid + 256, PROJ, QT, VT, PT, SN, F.onorm_g + L * 256, MIX);
        attn_combine(F, (const bf16*)F.out, (const bf16*)F.out + (size_t)T * 1024, (const bf16*)(F.ws + WS_OP2), (const float*)(F.ws + WS_LP), MIX);
        PH_END(P0 + 3); }
    if (PH_IN(P0 + 4)) {
        pg8::Gemm g{MIX, (const bf16*)(F.ws + WS_WOUT + L * SZ_WOUT), T, DM, DM}; pg8::StaticOrder S; S.init(T, DM, F.G, F.bid);
        { pg8::EpiResB<false> E{nullptr, XB, XB, DM, SSQ + (2 * L + 1) * T}; pg8::gemm_phase<pg8::EpiResB<false>, pg8::StaticOrder, true, true>(F.lds, g, S, E); }
        PH_END(P0 + 4); }
    if (PH_IN(P0 + 5)) {
        pg8::Gemm g{XB, (const bf16*)(F.ws + WS_WGU + L * SZ_WGU), T, NGU, DM}; pg8::StaticOrder S; S.init(T, NGU, F.G, F.bid);
        pg8::EpiSwiglu E{HMID, FFN, SSQ + (2 * L + 1) * T};
        pg8::gemm_phase<pg8::EpiSwiglu, pg8::StaticOrder, true, true>(F.lds, g, S, E);
        PH_END(P0 + 5); }
    if (PH_IN(P0 + 6)) {
        pg8::Gemm g{HMID, (const bf16*)(F.ws + WS_WD + L * SZ_WD), T, DM, FFN}; pg8::StaticOrder S; S.init(T, DM, F.G, F.bid);
        if (L + 1 < DEPTH) { pg8::EpiResB<false> E{nullptr, XB, XB, DM, SSQ + (2 * L + 2) * T}; pg8::gemm_phase<pg8::EpiResB<false>, pg8::StaticOrder, true, true>(F.lds, g, S, E); }
        else { pg8::EpiResF E{XB, F.out, DM}; pg8::gemm_phase<pg8::EpiResF, pg8::StaticOrder, true, true>(F.lds, g, S, E); }
        PH_END(P0 + 6); }
}
__global__ void __launch_bounds__(NTHR, 2) fwd(Args a) {
    extern __shared__ __attribute__((aligned(16))) unsigned char lds_raw[];
#ifdef CODE_SHIFT_NOPS
    asm volatile(".rept " CODE_SHIFT_STR "\n\ts_nop 0\n\t.endr" ::: "memory");
#endif
    Ctx F;
    F.lds = (LAS unsigned char*)lds_raw; F.tid = threadIdx.x; F.lane = F.tid & 63; F.wave = __builtin_amdgcn_readfirstlane(F.tid >> 6); F.G = gridDim.x; F.bid = blockIdx.x;
    F.x = a.in[0]; F.norm1_g = a.in[1]; F.w_in = a.in[2]; F.gate_w2 = a.in[3]; F.gate_b = a.in[4]; F.onorm_g = a.in[5]; F.qn_g = a.in[6]; F.kn_g = a.in[7]; F.rel_bias = a.in[8];
    F.w_out = a.in[9]; F.norm2_g = a.in[10]; F.w_gate = a.in[11]; F.w_up = a.in[12]; F.w_down = a.in[13]; F.out = a.out; F.ws = a.ws;
    const int lo = a.ph_lo, hi = a.ph_hi;
    cg::grid_group grid = cg::this_grid();
    if (hi > NPHASE) grid.sync();
    { volatile LAS unsigned* st = (volatile LAS unsigned*)(F.lds + LDS_BYTES - 64); if (F.tid < 2) st[F.tid] = 0u; __syncthreads();
      F.bar = xcd_barrier_post((unsigned*)(F.ws + WS_CTL) + 4096, st); }
    if (PH_IN(0)) { phase_convert(F); }
    if (PH_IN(1)) { phase_norm(F, F.x, (bf16*)(F.ws + WS_XB), (float*)(F.ws + WS_SSQ)); PH_END(1); }
    layer_phases<0>(F, lo, hi, grid);
    layer_phases<1>(F, lo, hi, grid);
}

extern "C" void kernel_launch(void* const* d_in, const int* in_sizes, int n_in, void* d_out, int out_size, void* d_ws, size_t ws_size, hipStream_t stream) {
    static int grid = 0;
    if (grid == 0) {
        if (n_in != 14 || out_size != T * DM || ws_size < WS_END) { fprintf(stderr, "kernel_launch: unexpected shapes (n_in %d, out %d, ws %zu)\n", n_in, out_size, ws_size); grid = -1; return; }
        if (hipFuncSetAttribute((const void*)fwd, hipFuncAttributeMaxDynamicSharedMemorySize, LDS_BYTES) != hipSuccess) { fprintf(stderr, "kernel_launch: hipFuncSetAttribute failed\n"); grid = -1; return; }
        int dev = 0, cus = 0, per_cu = 0;
        (void)hipGetDevice(&dev); (void)hipDeviceGetAttribute(&cus, hipDeviceAttributeMultiprocessorCount, dev);
        (void)hipOccupancyMaxActiveBlocksPerMultiprocessor(&per_cu, (const void*)fwd, NTHR, LDS_BYTES);
        if (per_cu < 1 || cus < 1) { fprintf(stderr, "kernel_launch: occupancy query says %d blocks/CU on %d CUs\n", per_cu, cus); grid = -1; return; }
        if (cus < 256) { fprintf(stderr, "kernel_launch: built for a 256-CU device (found %d CUs)\n", cus); grid = -1; return; }
        grid = 256;
    }
    if (grid < 0) return;
    Args a{};
    for (int i = 0; i < 14; ++i) a.in[i] = (const float*)d_in[i];
    a.out = (float*)d_out; a.ws = (unsigned char*)d_ws; a.ph_lo = 0; a.ph_hi = NPHASE;
    if (hipMemsetAsync((char*)d_ws + WS_CTL, 0, CTL_ZERO_BYTES, stream) != hipSuccess) { fprintf(stderr, "kernel_launch: hipMemsetAsync failed\n"); return; }
    void* kargs[] = {&a};
    const hipError_t e = hipLaunchCooperativeKernel((const void*)fwd, dim3(grid), dim3(NTHR), kargs, LDS_BYTES, stream);
    if (e != hipSuccess) fprintf(stderr, "kernel_launch: cooperative launch failed: %s (grid %d)\n", hipGetErrorString(e), grid);
}
```
